# Optimizing an MI355X kernel written in HIP

```python
import jax, jax.numpy as jnp
from jax import lax
import numpy as np

D_MODEL = 2048
BATCH = 8
SEQ = 4096
DEPTH = 4

HEAD_DIM = 64
N_MIX_HEADS = D_MODEL // HEAD_DIM
MIX_WIDTH = N_MIX_HEADS * HEAD_DIM
A_HEADS = N_MIX_HEADS // 4
A_KV_HEADS = 2
A_WINDOW = 128
A_BLOCK = 128
B_HEADS = N_MIX_HEADS // 4
MOBA_BLOCK = 256
MOBA_TOPK = 3
MOBA_Q_CHUNK = 32
C_HEADS = N_MIX_HEADS - A_HEADS - B_HEADS
C_PATTERNS = ((128, 1), (512, 4), (2048, 16))
MEM_LEN = 256
X_HEADS = 4
X_HEAD_DIM = 128
X_WIDTH = X_HEADS * X_HEAD_DIM
D_FF = -(-8 * D_MODEL // (3 * 256)) * 256
EPS = 1e-5

SPLIT_WIDTHS = (A_HEADS * HEAD_DIM, A_KV_HEADS * HEAD_DIM, A_KV_HEADS * HEAD_DIM,
                B_HEADS * HEAD_DIM, B_HEADS * HEAD_DIM, B_HEADS * HEAD_DIM,
                C_HEADS * HEAD_DIM, C_HEADS * HEAD_DIM, C_HEADS * HEAD_DIM)
IN_WIDTH = sum(SPLIT_WIDTHS)

kernel_name = 'hybrid_swa_moba_dilated_trunk'


def rmsnorm(x, g):
    xf = x.astype(jnp.float32)
    y = xf * lax.rsqrt(jnp.mean(xf * xf, axis=-1, keepdims=True) + EPS)
    return (y * g.astype(jnp.float32)).astype(x.dtype)


def alibi_slopes(n):
    return jnp.asarray(2.0 ** (-8.0 * np.arange(1, n + 1) / n), jnp.float32)


def with_prev_block(x):
    prev = jnp.concatenate([jnp.zeros_like(x[..., :1, :, :]), x[..., :-1, :, :]], axis=-3)
    return jnp.concatenate([prev, x], axis=-2)


def sliding_window_sink_attn(q, k, v, sinks):
    B, Hk, G, S, hd = q.shape
    f32 = jnp.float32
    nb = S // A_BLOCK
    qb = q.reshape(B, Hk, G, nb, A_BLOCK, hd)
    kb = with_prev_block(k.reshape(B, Hk, nb, A_BLOCK, hd))
    vb = with_prev_block(v.reshape(B, Hk, nb, A_BLOCK, hd))
    s = jnp.einsum('bkgnqd,bknsd->bkgnqs', qb, kb).astype(f32) * (hd ** -0.5)
    dist = jnp.arange(A_BLOCK)[:, None] + A_BLOCK - jnp.arange(2 * A_BLOCK)[None, :]
    kpos_ok = ((jnp.arange(nb)[:, None] - 1) * A_BLOCK + jnp.arange(2 * A_BLOCK)[None, :]) >= 0
    valid = ((dist >= 0) & (dist < A_WINDOW))[None] & kpos_ok[:, None, :]
    slopes = alibi_slopes(Hk * G).reshape(Hk, G)[:, :, None, None, None]
    s = jnp.where(valid, s - slopes * dist.astype(f32), -jnp.inf)
    sink = sinks.astype(f32).reshape(Hk, G)[:, :, None, None, None]
    m = jnp.maximum(jnp.max(s, axis=-1, keepdims=True), sink)
    p = jnp.exp(s - m)
    p = p / (jnp.sum(p, axis=-1, keepdims=True) + jnp.exp(sink - m))
    o = jnp.einsum('bkgnqs,bknsd->bkgnqd', p.astype(v.dtype), vb)
    return o.reshape(B, Hk, G, S, hd)


def moba_attn(q, k, v):
    B, H, S, hd = q.shape
    f32 = jnp.float32
    sp = -(-S // MOBA_BLOCK) * MOBA_BLOCK
    pad = ((0, 0), (0, 0), (0, sp - S), (0, 0))
    q, k, v = jnp.pad(q, pad), jnp.pad(k, pad), jnp.pad(v, pad)
    nb = sp // MOBA_BLOCK
    kb = k.reshape(B, H, nb, MOBA_BLOCK, hd)
    vb = v.reshape(B, H, nb, MOBA_BLOCK, hd)
    n_sel = min(MOBA_TOPK, nb - 1)
    scale = hd ** -0.5
    slopes = alibi_slopes(H)
    QC = MOBA_Q_CHUNK
    nc = sp // QC
    qc = q.reshape(B, H, nc, QC, hd).transpose(2, 0, 1, 3, 4)
    xs = (jnp.arange(nc), qc)
    if n_sel > 0:
        kmean = jnp.mean(kb.astype(f32), axis=3)
        gate = jnp.einsum('bhtd,bhnd->bhtn', q.astype(f32), kmean)
        past = jnp.arange(nb)[None, :] < (jnp.arange(sp) // MOBA_BLOCK)[:, None]
        gate = jnp.where(past, gate, -jnp.inf)
        _, sel = lax.top_k(gate, n_sel)
        xs = xs + (sel.reshape(B, H, nc, QC, n_sel).transpose(2, 0, 1, 3, 4),)

    def chunk(args):
        ci, qi = args[0], args[1]
        t = ci * QC + jnp.arange(QC)
        blk = (ci * QC) // MOBA_BLOCK
        k_own = lax.dynamic_index_in_dim(kb, blk, axis=2, keepdims=False)
        v_own = lax.dynamic_index_in_dim(vb, blk, axis=2, keepdims=False)
        dist_own = t[:, None] - (blk * MOBA_BLOCK + jnp.arange(MOBA_BLOCK))[None, :]
        s_own = jnp.einsum('bhqd,bhsd->bhqs', qi, k_own).astype(f32) * scale - slopes[:, None, None] * dist_own.astype(f32)
        s_own = jnp.where(dist_own >= 0, s_own, -jnp.inf)
        if n_sel == 0:
            p = jax.nn.softmax(s_own, axis=-1).astype(v.dtype)
            return jnp.einsum('bhqs,bhsd->bhqd', p, v_own)
        si = args[2]
        bi = jnp.arange(B)[:, None, None, None]
        hi = jnp.arange(H)[None, :, None, None]
        k_sel = kb[bi, hi, si]
        v_sel = vb[bi, hi, si]
        dist_sel = t[:, None, None] - (si[..., None] * MOBA_BLOCK + jnp.arange(MOBA_BLOCK))
        s_sel = jnp.einsum('bhqd,bhqrsd->bhqrs', qi, k_sel).astype(f32) * scale - slopes[:, None, None, None] * dist_sel.astype(f32)
        s_sel = jnp.where((si < blk)[..., None], s_sel, -jnp.inf)
        s_all = jnp.concatenate([s_sel.reshape(B, H, QC, n_sel * MOBA_BLOCK), s_own], axis=-1)
        p = jax.nn.softmax(s_all, axis=-1).astype(v.dtype)
        p_sel = p[..., :n_sel * MOBA_BLOCK].reshape(B, H, QC, n_sel, MOBA_BLOCK)
        return (jnp.einsum('bhqrs,bhqrsd->bhqd', p_sel, v_sel)
                + jnp.einsum('bhqs,bhsd->bhqd', p[..., n_sel * MOBA_BLOCK:], v_own))

    o = lax.map(chunk, xs)
    return o.transpose(1, 2, 0, 3, 4).reshape(B, H, sp, hd)[:, :, :S]


def _residue_major(x, d, sp):
    B, H, S, e = x.shape
    x = jnp.pad(x, ((0, 0), (0, 0), (0, sp - S), (0, 0)))
    return x.reshape(B, H, sp // d, d, e).transpose(0, 1, 3, 2, 4)


def _seq_major(x, sp):
    B, H, d, L, e = x.shape
    return x.transpose(0, 1, 3, 2, 4).reshape(B, H, sp, e)


def dilated_mixture_attn(q, k, v):
    B, H, S, hd = q.shape
    f32 = jnp.float32
    scale = hd ** -0.5
    slopes = alibi_slopes(H)[:, None, None, None, None]
    outs, lses = [], []
    for (w, d) in C_PATTERNS:
        n = w // d
        unit = d * n
        sp = -(-S // unit) * unit
        L = sp // d
        nb = L // n
        qs = _residue_major(q, d, sp).reshape(B, H, d, nb, n, hd)
        ks = with_prev_block(_residue_major(k, d, sp).reshape(B, H, d, nb, n, hd))
        vs = with_prev_block(_residue_major(v, d, sp).reshape(B, H, d, nb, n, hd))
        s = jnp.einsum('bhrnqd,bhrnsd->bhrnqs', qs, ks).astype(f32) * scale
        step = jnp.arange(n)[:, None] + n - jnp.arange(2 * n)[None, :]
        kpos_ok = ((jnp.arange(nb)[:, None] - 1) * n + jnp.arange(2 * n)[None, :]) >= 0
        valid = ((step >= 0) & (step <= n))[None] & kpos_ok[:, None, :]
        s = jnp.where(valid, s - slopes * (step * d).astype(f32), -jnp.inf)
        m = jnp.max(s, axis=-1, keepdims=True)
        p = jnp.exp(s - m)
        l = jnp.sum(p, axis=-1, keepdims=True)
        o = jnp.einsum('bhrnqs,bhrnsd->bhrnqd', (p / l).astype(v.dtype), vs)
        outs.append(_seq_major(o.reshape(B, H, d, L, hd), sp)[:, :, :S])
        lses.append(_seq_major((m + jnp.log(l)).reshape(B, H, d, L, 1), sp)[:, :, :S])
    wts = jax.nn.softmax(jnp.stack(lses), axis=0)
    o = jnp.sum(wts * jnp.stack(outs).astype(f32), axis=0)
    return o.astype(q.dtype)


def _heads(x, n):
    B, S, _ = x.shape
    return x.reshape(B, S, n, HEAD_DIM).transpose(0, 2, 1, 3)


def _merge(x):
    B, H, S, hd = x.shape
    return x.transpose(0, 2, 1, 3).reshape(B, S, H * hd)


def hybrid_mixer(a, w_in, sinks, gain_a, gain_b, gain_c, w_out):
    B, S, _ = a.shape
    proj = a @ w_in
    offsets = np.cumsum(SPLIT_WIDTHS)[:-1].tolist()
    qa, ka, va, qb, kb, vb, qc, kc, vc = jnp.split(proj, offsets, axis=-1)
    G = A_HEADS // A_KV_HEADS
    qa = qa.reshape(B, S, A_KV_HEADS, G, HEAD_DIM).transpose(0, 2, 3, 1, 4)
    oa = sliding_window_sink_attn(qa, _heads(ka, A_KV_HEADS), _heads(va, A_KV_HEADS), sinks)
    oa = oa.transpose(0, 3, 1, 2, 4).reshape(B, S, A_HEADS * HEAD_DIM)
    ob = _merge(moba_attn(_heads(qb, B_HEADS), _heads(kb, B_HEADS), _heads(vb, B_HEADS)))
    oc = _merge(dilated_mixture_attn(_heads(qc, C_HEADS), _heads(kc, C_HEADS), _heads(vc, C_HEADS)))
    y = jnp.concatenate([rmsnorm(oa, gain_a), rmsnorm(ob, gain_b), rmsnorm(oc, gain_c)], axis=-1)
    return y @ w_out


def memory_cross_attn(h, mem_n, wq, wk, wv, wo):
    B, S, _ = h.shape
    M = mem_n.shape[1]
    q = (h @ wq).reshape(B, S, X_HEADS, X_HEAD_DIM)
    k = (mem_n @ wk).reshape(B, M, X_HEADS, X_HEAD_DIM)
    v = (mem_n @ wv).reshape(B, M, X_HEADS, X_HEAD_DIM)
    s = jnp.einsum('bqhd,bmhd->bhqm', q, k).astype(jnp.float32) * (X_HEAD_DIM ** -0.5)
    p = jax.nn.softmax(s, axis=-1).astype(v.dtype)
    o = jnp.einsum('bhqm,bmhd->bqhd', p, v).reshape(B, S, X_WIDTH)
    return o @ wo


def swiglu(h, w_gate, w_up, w_down):
    return (jax.nn.silu(h @ w_gate) * (h @ w_up)) @ w_down


def setup_inputs(seed: int = 0) -> dict:
    key = jax.random.key(seed)
    ks = jax.random.split(key, 20)
    f32 = jnp.float32

    def w(k, fan_in, fan_out):
        return jax.random.normal(k, (DEPTH, fan_in, fan_out), f32) * fan_in ** -0.5

    def gain(k, n):
        return 1.0 + 0.02 * jax.random.normal(k, (DEPTH, n), f32)

    return {
        'x': jax.random.normal(ks[0], (BATCH, SEQ, D_MODEL), f32),
        'mem': jax.random.normal(ks[1], (BATCH, MEM_LEN, D_MODEL), f32),
        'norm_mix': gain(ks[2], D_MODEL),
        'w_in': w(ks[3], D_MODEL, IN_WIDTH),
        'sinks': 0.5 * jax.random.normal(ks[4], (DEPTH, A_HEADS), f32),
        'gain_a': gain(ks[5], A_HEADS * HEAD_DIM),
        'gain_b': gain(ks[6], B_HEADS * HEAD_DIM),
        'gain_c': gain(ks[7], C_HEADS * HEAD_DIM),
        'w_out': w(ks[8], MIX_WIDTH, D_MODEL),
        'norm_xattn': gain(ks[9], D_MODEL),
        'norm_mem': gain(ks[10], D_MODEL),
        'wq_x': w(ks[11], D_MODEL, X_WIDTH),
        'wk_x': w(ks[12], D_MODEL, X_WIDTH),
        'wv_x': w(ks[13], D_MODEL, X_WIDTH),
        'wo_x': w(ks[14], X_WIDTH, D_MODEL),
        'norm_ffn': gain(ks[15], D_MODEL),
        'w_gate': w(ks[16], D_MODEL, D_FF),
        'w_up': w(ks[17], D_MODEL, D_FF),
        'w_down': w(ks[18], D_FF, D_MODEL),
        'norm_final': 1.0 + 0.02 * jax.random.normal(ks[19], (D_MODEL,), f32),
    }


def reference(x, mem, norm_mix, w_in, sinks, gain_a, gain_b, gain_c, w_out,
              norm_xattn, norm_mem, wq_x, wk_x, wv_x, wo_x,
              norm_ffn, w_gate, w_up, w_down, norm_final):
    h = x
    for l in range(DEPTH):
        a = rmsnorm(h, norm_mix[l])
        h = h + hybrid_mixer(a, w_in[l], sinks[l], gain_a[l], gain_b[l], gain_c[l], w_out[l])
        mem_n = rmsnorm(mem, norm_mem[l])
        h = h + memory_cross_attn(rmsnorm(h, norm_xattn[l]), mem_n, wq_x[l], wk_x[l], wv_x[l], wo_x[l])
        h = h + swiglu(rmsnorm(h, norm_ffn[l]), w_gate[l], w_up[l], w_down[l])
    return rmsnorm(h, norm_final)
```

```cpp
#include <hip/hip_runtime.h>
#include <cstdio>
#include <cstdint>
template <int CTRL> __device__ __forceinline__ float lane_dpp(float v) { return __builtin_bit_cast(float, __builtin_amdgcn_update_dpp(0, __builtin_bit_cast(int, v), CTRL, 0xf, 0xf, true)); }
__device__ __forceinline__ float sum_row16(float v) {
    v += lane_dpp<0xB1>(v); v += lane_dpp<0x4E>(v); v += lane_dpp<0x141>(v); v += lane_dpp<0x140>(v); return v; }
__device__ __forceinline__ float sum_x16(float v) { return v + __builtin_bit_cast(float, __builtin_amdgcn_ds_swizzle(__builtin_bit_cast(int, v), 0x401f)); }
__device__ __forceinline__ void swap32(float v, float& a, float& b) { float x = v, y = v; asm volatile("s_nop 1\n\tv_permlane32_swap_b32 %0, %1" : "+v"(x), "+v"(y)); a = x; b = y; }
__device__ __forceinline__ float sum_x32(float v) { float a, b; swap32(v, a, b); return a + b; }
namespace pg8 {
#define PG8_LAS __attribute__((address_space(3)))
typedef unsigned short bf16_t;
typedef short bf16x8 __attribute__((ext_vector_type(8)));
typedef float f32x4 __attribute__((ext_vector_type(4)));
typedef unsigned u32x4 __attribute__((ext_vector_type(4)));
constexpr int BM = 256, BK = 64, HALF = 128, HTB = HALF * BK * 2  , STAGE_BYTES = 8 * HTB, NXCD = 8, WGM = 8;

__host__ __device__ __forceinline__ int lds_byte(int r, int c) { const int st = (r >> 4) * 2 + (c >> 5), rr = r & 15, cc = c & 31, ob = rr * 64 + cc * 2; return st * 1024 + (ob ^ (((ob >> 9) & 1) << 5)); }
__host__ __device__ __forceinline__ void stage_rc(int b, int& R, int& C) { const int st = b / 1024, sb = b % 1024, swz = sb ^ (((sb >> 9) & 1) << 5); R = (st >> 1) * 16 + swz / 64; C = (st & 1) * 32 + (swz % 64) / 2; }
__host__ __device__ __forceinline__ int perm32(int rho) { const int n = rho >> 4, i = rho & 15; return 8 * (i >> 2) + 4 * n + (i & 3); }

struct Unit { int pm, pn; };
struct Gemm { const bf16_t* A; const bf16_t* Bt; int M, N, K; };

struct StaticOrder {
    int nM, nN, nwg, G, c;
    __host__ __device__ void init(int M, int N, int G_, int c_) { nM = M / BM; nN = N / BM; nwg = nM * nN; G = G_; c = c_; }
    __host__ __device__ bool next(int i, Unit& u) const {
        const long L = (long)i * G + c; if (L >= nwg) return false;
        int wgid = (int)L; { const int q = nwg / NXCD, r = nwg % NXCD, xcd = wgid % NXCD, off = wgid / NXCD; wgid = (xcd < r ? xcd * (q + 1) : r * (q + 1) + (xcd - r) * q) + off; }
        const int nig = WGM * nN, gid = wgid / nig, fm = gid * WGM, gsz = (nM - fm) < WGM ? (nM - fm) : WGM;
        u.pm = fm + ((wgid % nig) % gsz); u.pn = (wgid % nig) / gsz; return true;
    }
    __device__ __forceinline__ void a_ready(const Unit&) const {}
    __device__ __forceinline__ void done(const Unit&) const {}
};


typedef unsigned wt_v4u __attribute__((ext_vector_type(4)));
__device__ __forceinline__ __amdgpu_buffer_rsrc_t wt_rsrc(const void* base) { return __builtin_amdgcn_make_buffer_rsrc((void*)base, (short)0, 0x7ffffff0, 0x00020000); }
__device__ __forceinline__ void wt_store16(__amdgpu_buffer_rsrc_t rs, size_t byteoff, u32x4 v) { __builtin_amdgcn_raw_buffer_store_b128(__builtin_bit_cast(wt_v4u, v), rs, (int)(unsigned)byteoff, 0, 16); }
__device__ __forceinline__ unsigned cvt_pk_bf16(float lo, float hi) { unsigned r; asm volatile("v_cvt_pk_bf16_f32 %0, %1, %2" : "=v"(r) : "v"(lo), "v"(hi)); return r; }

#ifndef SS_ATOMIC
#define SS_ATOMIC 1
#endif
__device__ __forceinline__ float rstd_of(unsigned long long q) { const float s = (float)(unsigned)(q >> 32) + (float)(unsigned)q * (1.f / 4294967296.f); return __builtin_amdgcn_rsqf(s * (1.f / 2048.f) + 1e-5f); }
typedef __attribute__((address_space(3))) float lds_f32;
typedef __attribute__((address_space(3))) int lds_i32;
__device__ __forceinline__ void rstd_rows(float (&rs)[2][4], const unsigned long long* ss, int row0, int tag, lds_f32* stash  , int wid, int fr, int fq) {
    lds_f32* mine = stash + wid * 128; lds_i32* tagw = (lds_i32*)(stash + 8 * 128) + wid;
    const int have = __builtin_amdgcn_readfirstlane(*tagw);
    if (have == tag) {
#pragma unroll
        for (int ai = 0; ai < 2; ++ai)
#pragma unroll
            for (int m = 0; m < 4; ++m) rs[ai][m] = mine[ai * 64 + m * 16 + fr];
    } else {
        unsigned long long sv[2][4];
#pragma unroll
        for (int ai = 0; ai < 2; ++ai)
#pragma unroll
            for (int m = 0; m < 4; ++m) sv[ai][m] = ss[row0 + ai * HALF + m * 16];
#pragma unroll
        for (int ai = 0; ai < 2; ++ai)
#pragma unroll
            for (int m = 0; m < 4; ++m) { rs[ai][m] = rstd_of(sv[ai][m]); if (fq == 0) mine[ai * 64 + m * 16 + fr] = rs[ai][m]; }
        *tagw = tag;
    }
}
struct EpiBf16S {
    static constexpr bool PERM = true, AFTER_DRAIN = false;
    bf16_t* O; int ldc; float scale; unsigned smask; int pn_and; const unsigned long long* ss; float* km; lds_f32* stash; int tag0;
    __device__ __forceinline__ void operator()(const f32x4 (&acc)[2][2][4][2], const Unit& u, int wr, int wc, int fr, int fq) const {
        const int row0 = u.pm * BM + wr * 64 + fr; const int pn = u.pn & pn_and; const int col0 = pn * BM + wc * 32 + 8 * fq;
        const float sc = ((smask >> pn) & 1u) ? scale : 1.f;
        const bool dokm = (km != nullptr) && (pn == 5 || pn == 6);
        f32x4 cs[2][2];
#pragma unroll
        for (int bj = 0; bj < 2; ++bj) { cs[bj][0] = (f32x4){0.f, 0.f, 0.f, 0.f}; cs[bj][1] = (f32x4){0.f, 0.f, 0.f, 0.f}; }
        float rsv[2][4];
        if (ss) rstd_rows(rsv, ss, row0, tag0 + u.pm + 1, stash, wr * 4 + wc, fr, fq);
#pragma unroll
        for (int ai = 0; ai < 2; ++ai)
#pragma unroll
            for (int m = 0; m < 4; ++m) { const int row = row0 + ai * HALF + m * 16; const size_t ro = ((size_t)row * ldc + col0) * 2;
                float rs = sc; if (ss) rs *= rsv[ai][m];
#pragma unroll
                for (int bj = 0; bj < 2; ++bj) { f32x4 v0 = acc[ai][bj][m][0] * rs, v1 = acc[ai][bj][m][1] * rs;
                    cs[bj][0] += v0; cs[bj][1] += v1;
                    u32x4 w; w.x = cvt_pk_bf16(v0[0], v0[1]); w.y = cvt_pk_bf16(v0[2], v0[3]); w.z = cvt_pk_bf16(v1[0], v1[1]); w.w = cvt_pk_bf16(v1[2], v1[3]);
                    *(u32x4*)(O + (ro >> 1) + bj * HALF) = w; } }
        if (dokm) { float mine = 0.f;
#pragma unroll
            for (int bj = 0; bj < 2; ++bj)
#pragma unroll
                for (int n = 0; n < 2; ++n)
#pragma unroll
                    for (int i = 0; i < 4; ++i) { const float v = sum_row16(cs[bj][n][i]); mine = (fr == bj * 8 + n * 4 + i) ? v : mine; }
            unsafeAtomicAdd(km + (size_t)u.pm * 512 + (col0 - 1280) + (fr >> 3) * HALF + (fr & 7), mine); }
    }
};
struct EpiResid {
    static constexpr bool PERM = true, AFTER_DRAIN = false;
    const bf16_t* in; bf16_t* out; int ldc; unsigned long long* ss_out; __attribute__((address_space(3))) unsigned long long* lss;
    __device__ __forceinline__ void operator()(const f32x4 (&acc)[2][2][4][2], const Unit& u, int wr, int wc, int fr, int fq) const {
        const int row0 = u.pm * BM + wr * 64 + fr, col0 = u.pn * BM + wc * 32 + 8 * fq;
        u32x4 rin[2][4][2];
#pragma unroll
        for (int ai = 0; ai < 2; ++ai)
#pragma unroll
            for (int m = 0; m < 4; ++m)
#pragma unroll
                for (int bj = 0; bj < 2; ++bj) rin[ai][m][bj] = *(const u32x4*)(in + (size_t)(row0 + ai * HALF + m * 16) * ldc + col0 + bj * HALF);
#pragma unroll
        for (int ai = 0; ai < 2; ++ai)
#pragma unroll
            for (int m = 0; m < 4; ++m) { const int row = row0 + ai * HALF + m * 16; const size_t off = (size_t)row * ldc + col0;
                typedef float f32x2 __attribute__((ext_vector_type(2)));
                f32x2 sq2 = {0.f, 0.f};
#pragma unroll
                for (int bj = 0; bj < 2; ++bj) { const u32x4 w0 = rin[ai][m][bj];
                    const f32x4 a0 = acc[ai][bj][m][0], a1 = acc[ai][bj][m][1];
                    f32x2 p0 = (f32x2){a0[0], a0[1]} + (f32x2){__builtin_bit_cast(float, w0.x << 16), __builtin_bit_cast(float, w0.x & 0xffff0000u)};
                    f32x2 p1 = (f32x2){a0[2], a0[3]} + (f32x2){__builtin_bit_cast(float, w0.y << 16), __builtin_bit_cast(float, w0.y & 0xffff0000u)};
                    f32x2 p2 = (f32x2){a1[0], a1[1]} + (f32x2){__builtin_bit_cast(float, w0.z << 16), __builtin_bit_cast(float, w0.z & 0xffff0000u)};
                    f32x2 p3 = (f32x2){a1[2], a1[3]} + (f32x2){__builtin_bit_cast(float, w0.w << 16), __builtin_bit_cast(float, w0.w & 0xffff0000u)};
                    sq2 = __builtin_elementwise_fma(p0, p0, sq2); sq2 = __builtin_elementwise_fma(p1, p1, sq2); sq2 = __builtin_elementwise_fma(p2, p2, sq2); sq2 = __builtin_elementwise_fma(p3, p3, sq2);
                    u32x4 w; w.x = cvt_pk_bf16(p0.x, p0.y); w.y = cvt_pk_bf16(p1.x, p1.y); w.z = cvt_pk_bf16(p2.x, p2.y); w.w = cvt_pk_bf16(p3.x, p3.y);
                    *(u32x4*)(out + off + bj * HALF) = w; }
                float sq = sq2.x + sq2.y;
                sq = sum_x32(sum_x16(sq));
                if (SS_ATOMIC && fq == 0) { const unsigned hi_ = (unsigned)sq, lo_ = (unsigned)((sq - (float)hi_) * 4294967296.f);
                    __hip_atomic_fetch_add(lss + (wr * 128 + ai * 64 + m * 16 + fr), ((unsigned long long)hi_ << 32) | lo_, __ATOMIC_RELAXED, __HIP_MEMORY_SCOPE_WORKGROUP); } }
        if (SS_ATOMIC) {
            asm volatile("s_waitcnt lgkmcnt(0)\n\ts_barrier" ::: "memory");
            const int ln = fq * 16 + fr;
            if (ln < 32) { const int d = wr * 128 + wc * 32 + ln; const unsigned long long v = lss[d]; lss[d] = 0ull;
                atomicAdd(ss_out + (u.pm * BM + ((d >> 6) & 1) * HALF + wr * 64 + ((d >> 4) & 3) * 16 + (d & 15)), v); } }
    }
};
struct EpiSwiGLU {
    static constexpr bool PERM = true, AFTER_DRAIN = false;
    bf16_t* O; int ldc; const unsigned long long* ss; int nostore; lds_f32* stash; int tag0;
    __device__ __forceinline__ void operator()(const f32x4 (&acc)[2][2][4][2], const Unit& u, int wr, int wc, int fr, int fq) const {
        if (nostore == 2) return;
        const int row0 = u.pm * BM + wr * 64 + fr, col0 = u.pn * HALF + wc * 32 + 8 * fq;
        float rsv[2][4];
        rstd_rows(rsv, ss, row0, tag0 + u.pm + 1, stash, wr * 4 + wc, fr, fq);
#pragma unroll
        for (int ai = 0; ai < 2; ++ai)
#pragma unroll
            for (int m = 0; m < 4; ++m) { const int row = row0 + ai * HALF + m * 16; const size_t ro = ((size_t)row * ldc + col0) * 2;
                typedef float f32x2 __attribute__((ext_vector_type(2)));
                const float rs = rsv[ai][m], c1 = -1.4426950408889634f * rs, rs2 = rs * rs;
                f32x2 G[4], U[4], T[4];
#pragma unroll
                for (int i = 0; i < 4; ++i) { G[i] = (f32x2){acc[ai][0][m][i >> 1][2 * (i & 1)], acc[ai][0][m][i >> 1][2 * (i & 1) + 1]}; U[i] = (f32x2){acc[ai][1][m][i >> 1][2 * (i & 1)], acc[ai][1][m][i >> 1][2 * (i & 1) + 1]}; }
#pragma unroll
                for (int i = 0; i < 4; ++i) T[i] = G[i] * c1;
#pragma unroll
                for (int i = 0; i < 4; ++i) T[i] = (f32x2){__builtin_amdgcn_exp2f(T[i].x), __builtin_amdgcn_exp2f(T[i].y)};
#pragma unroll
                for (int i = 0; i < 4; ++i) T[i] = T[i] + 1.f;
#pragma unroll
                for (int i = 0; i < 4; ++i) T[i] = (f32x2){__builtin_amdgcn_rcpf(T[i].x), __builtin_amdgcn_rcpf(T[i].y)};
#pragma unroll
                for (int i = 0; i < 4; ++i) T[i] = ((G[i] * U[i]) * T[i]) * rs2;
                u32x4 w; w.x = cvt_pk_bf16(T[0].x, T[0].y); w.y = cvt_pk_bf16(T[1].x, T[1].y); w.z = cvt_pk_bf16(T[2].x, T[2].y); w.w = cvt_pk_bf16(T[3].x, T[3].y);
                if (!nostore) *(u32x4*)(O + (ro >> 1)) = w; }
    }
};
struct TeamOrder {
    int nN, t, r;
    __device__ __forceinline__ bool next(int i, Unit& u) const { const int li = i * 32 + r; if (li >= 16 * nN) return false; const int gid = li / (8 * nN), idx = li % (8 * nN);
        u.pm = 16 * t + 8 * gid + (idx & 7); u.pn = idx >> 3; return true; }
    __device__ __forceinline__ void a_ready(const Unit&) const {}
    __device__ __forceinline__ void done(const Unit&) const {}
};
struct OneUnit {
    int pm, pn;
    __device__ __forceinline__ bool next(int i, Unit& u) const { if (i != 0) return false; u.pm = pm; u.pn = pn; return true; }
    __device__ __forceinline__ void a_ready(const Unit&) const {}
    __device__ __forceinline__ void done(const Unit&) const {}
};
struct KvOrder {
    int G, c;
    __device__ __forceinline__ bool next(int i, Unit& u) const { const int L = i * G + c; if (L >= 128) return false; u.pm = L >> 2; u.pn = ((L >> 5) << 2) + (L & 3); return true; }
    __device__ __forceinline__ void a_ready(const Unit&) const {}
    __device__ __forceinline__ void done(const Unit&) const {}
};
template <class Epi, class Sched, bool ALIGN_EPI = false, bool SP2 = false>
__device__ __forceinline__ void gemm_phase(PG8_LAS unsigned char* lds, const Gemm g, const Sched& S, const Epi& E, const int wave_id  ) {
    unsigned z_ = 0u; asm volatile("" : "+s"(z_));
    int tid_ = wave_id * 64 + (int)__builtin_amdgcn_mbcnt_hi(~0u, __builtin_amdgcn_mbcnt_lo(~0u, z_));
    const int tid = tid_, wid = __builtin_amdgcn_readfirstlane(tid >> 6), lane = tid & 63, wr = wid >> 2, wc = wid & 3, fr = lane & 15, fq = lane >> 4;
    const int K = g.K, nt = K / BK;
    unsigned voffA[2], voffB[2];
#pragma unroll
    for (int i = 0; i < 2; ++i) { int R, C; stage_rc(tid * 16 + i * 8192, R, C); const int Rb = Epi::PERM ? ((R & ~31) + perm32(R & 31)) : R;
        voffA[i] = (unsigned)(R * K + C) * 2u; voffB[i] = (unsigned)(Rb * K + C) * 2u; }
    const size_t kstep = (size_t)(BK * 2);
    const size_t hstep = (size_t)HALF * K * 2;
    const size_t tstep = 2 * hstep;
    const unsigned ldsw = (unsigned)wid * 1024u;
    const int aoff = lds_byte(wr * 64 + fr, fq * 8), boff = lds_byte(wc * 32 + fr, fq * 8);
#define PG8_SA(b, h) (((b) * 2 + (h)) * HTB)
#define PG8_SB(b, h) ((4 + (b) * 2 + (h)) * HTB)
#define PG8_STAGE(bufoff, gbase, voff) do { _Pragma("unroll") for (int _i = 0; _i < 2; ++_i) \
        __builtin_amdgcn_global_load_lds((const unsigned*)((const char*)(gbase) + (voff)[_i]), (PG8_LAS unsigned*)(lds + (bufoff) + ldsw + _i * 8192), 16, 0, 0); } while (0)
#define PG8_LDA(dst, b, h) do { _Pragma("unroll") for (int m = 0; m < 4; ++m) _Pragma("unroll") for (int k = 0; k < 2; ++k) dst[m][k] = *(const PG8_LAS bf16x8*)(lds + PG8_SA(b, h) + aoff + m * 2048 + k * 1024); } while (0)
#define PG8_LDB(dst, b, h) do { _Pragma("unroll") for (int n = 0; n < 2; ++n) _Pragma("unroll") for (int k = 0; k < 2; ++k) dst[n][k] = *(const PG8_LAS bf16x8*)(lds + PG8_SB(b, h) + boff + n * 2048 + k * 1024); } while (0)
#define PG8_MMA(ai, bj, At, Bt) do { __builtin_amdgcn_s_setprio(1); _Pragma("unroll") for (int m = 0; m < 4; ++m) _Pragma("unroll") for (int n = 0; n < 2; ++n) _Pragma("unroll") for (int k = 0; k < 2; ++k) \
        acc[ai][bj][m][n] = __builtin_amdgcn_mfma_f32_16x16x32_bf16(Bt[n][k], At[m][k], acc[ai][bj][m][n], 0, 0, 0); __builtin_amdgcn_s_setprio(0); } while (0)
#define PG8_WAIT_V(n) asm volatile("s_waitcnt vmcnt(" #n ")" ::: "memory")
#define PG8_WAIT_L(n) asm volatile("s_waitcnt lgkmcnt(" #n ")" ::: "memory")
#define PG8_BAR __builtin_amdgcn_s_barrier()
#define PG8_SCHED __builtin_amdgcn_sched_barrier(0)
    Unit cur, nxt; int ui = 0;
    if (!S.next(0, cur)) return;
    f32x4 acc[2][2][4][2];
#pragma unroll
    for (int a = 0; a < 2; ++a)
#pragma unroll
        for (int b = 0; b < 2; ++b)
#pragma unroll
            for (int m = 0; m < 4; ++m)
#pragma unroll
                for (int n = 0; n < 2; ++n) acc[a][b][m][n] = (f32x4){0.f, 0.f, 0.f, 0.f};
    bf16x8 At[4][2], B0[2][2], B1[2][2];
    const char* cA = (const char*)g.A + (size_t)cur.pm * tstep; const char* cB = (const char*)g.Bt + (size_t)cur.pn * tstep;
    S.a_ready(cur);
    if constexpr (SP2) {
        PG8_STAGE(PG8_SB(0, 0), cB, voffB); PG8_STAGE(PG8_SB(0, 1), cB + hstep, voffB); PG8_STAGE(PG8_SA(0, 0), cA, voffA); PG8_STAGE(PG8_SA(0, 1), cA + hstep, voffA);
        if (wr == 1) PG8_BAR;
        PG8_WAIT_V(2); PG8_BAR;
        PG8_STAGE(PG8_SB(1, 0), cB + kstep, voffB); PG8_STAGE(PG8_SA(1, 0), cA + kstep, voffA); PG8_STAGE(PG8_SB(1, 1), cB + hstep + kstep, voffB);
        PG8_WAIT_V(6); PG8_BAR;
    } else {
        PG8_STAGE(PG8_SB(0, 0), cB, voffB); PG8_STAGE(PG8_SA(0, 0), cA, voffA); PG8_STAGE(PG8_SB(0, 1), cB + hstep, voffB); PG8_STAGE(PG8_SA(0, 1), cA + hstep, voffA);
        if (wr == 1) PG8_BAR;
        PG8_WAIT_V(4); PG8_BAR;
        PG8_STAGE(PG8_SB(1, 0), cB + kstep, voffB); PG8_STAGE(PG8_SA(1, 0), cA + kstep, voffA); PG8_STAGE(PG8_SB(1, 1), cB + hstep + kstep, voffB);
        PG8_WAIT_V(6); PG8_BAR;
    }
    for (;;) {
        const bool has_next = S.next(ui + 1, nxt);
        const char* nA = has_next ? (const char*)g.A + (size_t)nxt.pm * tstep : cA; const char* nB = has_next ? (const char*)g.Bt + (size_t)nxt.pn * tstep : cB;
        for (int t = 0; t < nt; t += 2) {
            const bool last = (t == nt - 2);
            const char* a1 = cA + (size_t)(t + 1) * kstep;
            const char* a2 = last ? nA : cA + (size_t)(t + 2) * kstep; const char* b2 = last ? nB : cB + (size_t)(t + 2) * kstep;
            const char* a3 = a2 + kstep; const char* b3 = b2 + kstep;
            if (last && has_next) S.a_ready(nxt);
            if constexpr (SP2) {
            PG8_LDB(B0, 0, 0); PG8_LDB(B1, 0, 1); PG8_SCHED; PG8_LDA(At, 0, 0); PG8_STAGE(PG8_SA(1, 1), a1 + hstep, voffA);
            PG8_WAIT_V(8); PG8_WAIT_L(0); PG8_BAR; PG8_MMA(0, 0, At, B0); PG8_MMA(0, 1, At, B1); PG8_BAR; PG8_SCHED;
            PG8_LDA(At, 0, 1); PG8_STAGE(PG8_SB(0, 0), b2, voffB); PG8_STAGE(PG8_SB(0, 1), b2 + hstep, voffB); PG8_STAGE(PG8_SA(0, 0), a2, voffA);
            PG8_WAIT_V(8); PG8_WAIT_L(0); PG8_BAR; PG8_MMA(1, 0, At, B0); PG8_MMA(1, 1, At, B1); PG8_BAR; PG8_SCHED;
            PG8_LDB(B0, 1, 0); PG8_LDB(B1, 1, 1); PG8_SCHED; PG8_LDA(At, 1, 0); PG8_STAGE(PG8_SA(0, 1), a2 + hstep, voffA);
            PG8_WAIT_V(8); PG8_WAIT_L(0); PG8_BAR; PG8_MMA(0, 0, At, B0); PG8_MMA(0, 1, At, B1); PG8_BAR; PG8_SCHED;
            PG8_LDA(At, 1, 1); PG8_STAGE(PG8_SB(1, 0), b3, voffB); PG8_STAGE(PG8_SB(1, 1), b3 + hstep, voffB); PG8_STAGE(PG8_SA(1, 0), a3, voffA);
            PG8_WAIT_V(8); PG8_WAIT_L(0); PG8_BAR; PG8_MMA(1, 0, At, B0); PG8_MMA(1, 1, At, B1); PG8_BAR; PG8_SCHED;
            } else {
            PG8_LDB(B0, 0, 0); PG8_SCHED; PG8_LDA(At, 0, 0); PG8_STAGE(PG8_SA(1, 1), a1 + hstep, voffA);
            PG8_WAIT_L(8); PG8_BAR; PG8_WAIT_L(0); PG8_MMA(0, 0, At, B0); PG8_BAR; PG8_SCHED;
            PG8_LDB(B1, 0, 1); PG8_STAGE(PG8_SB(0, 0), b2, voffB);
            PG8_BAR; PG8_WAIT_L(0); PG8_MMA(0, 1, At, B1); PG8_BAR;
            PG8_LDA(At, 0, 1); PG8_STAGE(PG8_SA(0, 0), a2, voffA);
            PG8_BAR; PG8_WAIT_L(0); PG8_MMA(1, 0, At, B0); PG8_BAR; PG8_SCHED;
            PG8_STAGE(PG8_SB(0, 1), b2 + hstep, voffB);
            PG8_WAIT_V(6); PG8_BAR; PG8_MMA(1, 1, At, B1); PG8_BAR;
            PG8_LDB(B0, 1, 0); PG8_SCHED; PG8_LDA(At, 1, 0); PG8_STAGE(PG8_SA(0, 1), a2 + hstep, voffA);
            PG8_WAIT_L(8); PG8_BAR; PG8_WAIT_L(0); PG8_MMA(0, 0, At, B0); PG8_BAR; PG8_SCHED;
            PG8_LDB(B1, 1, 1); PG8_STAGE(PG8_SB(1, 0), b3, voffB);
            PG8_BAR; PG8_WAIT_L(0); PG8_MMA(0, 1, At, B1); PG8_BAR;
            PG8_LDA(At, 1, 1); PG8_STAGE(PG8_SA(1, 0), a3, voffA);
            PG8_BAR; PG8_WAIT_L(0); PG8_MMA(1, 0, At, B0); PG8_BAR; PG8_SCHED;
            PG8_STAGE(PG8_SB(1, 1), b3 + hstep, voffB);
            PG8_WAIT_V(6); PG8_BAR; PG8_MMA(1, 1, At, B1); PG8_BAR;
            }
        }
        if constexpr (ALIGN_EPI) { if (wr == 0) PG8_BAR; }
        if constexpr (!Epi::AFTER_DRAIN) { E(acc, cur, wr, wc, fr, fq); S.done(cur); }
        if (!has_next) break;
#pragma unroll
        for (int a = 0; a < 2; ++a)
#pragma unroll
            for (int b = 0; b < 2; ++b)
#pragma unroll
                for (int m = 0; m < 4; ++m)
#pragma unroll
                    for (int n = 0; n < 2; ++n) acc[a][b][m][n] = (f32x4){0.f, 0.f, 0.f, 0.f};
        cur = nxt; cA = nA; cB = nB; ++ui;
        if constexpr (ALIGN_EPI) { if (wr == 1) PG8_BAR; }
    }
    PG8_WAIT_V(0);
    if constexpr (!ALIGN_EPI) { if (wr == 0) PG8_BAR; }
    PG8_BAR;
    if constexpr (Epi::AFTER_DRAIN) { E.fused(acc, cur, wr, wc, fr, fq, lds, wid, lane); S.done(cur); }
#undef PG8_SA
#undef PG8_SB
#undef PG8_STAGE
#undef PG8_LDA
#undef PG8_LDB
#undef PG8_MMA
#undef PG8_WAIT_V
#undef PG8_WAIT_L
#undef PG8_BAR
#undef PG8_SCHED
}
}

constexpr int NWAVES = 8;
constexpr int BATCH = 8, SEQ = 4096, DM = 2048, DEPTH = 4, M = BATCH * SEQ;
constexpr int INW = 5376, DFF = 5632, NGU = 2 * DFF, XW = 512, MEML = 256, MROWS = BATCH * MEML;
constexpr int QA = 0, KA = 512, VA = 640, QB = 768, KB = 1280, VB = 1792, QC = 2304, KC = 3328, VC = 4352;
constexpr float LOG2E = 1.4426950408889634f;
constexpr float C2 = 0.125f * LOG2E;
constexpr float CX2 = 0.08838834764831845f * LOG2E;
constexpr float EPS = 1e-5f;

constexpr size_t MiB = 1u << 20;
constexpr size_t WS_CTL = 0, CTL_ZERO_BYTES = 4 * MiB;
constexpr size_t WS_KMEAN = 1 * MiB;
constexpr size_t WS_WL = 4 * MiB, WL_STRIDE = 99 * MiB;
constexpr size_t WL_IN = 0, WL_OUT = 21 * MiB, WL_Q = 29 * MiB, WL_O = 31 * MiB, WL_GU = 33 * MiB, WL_DN = 77 * MiB;
constexpr size_t WS_WKV = 400 * MiB;
constexpr size_t WS_KVX = 416 * MiB;
constexpr size_t WS_XN = 432 * MiB;
constexpr size_t WS_BIG = 560 * MiB;
constexpr size_t WS_QX = WS_XN, WS_OX = WS_XN + 32 * MiB;
constexpr size_t WS_PART = 912 * MiB;
constexpr size_t WS_LSE = WS_PART + 128 * MiB;
constexpr size_t WS_SS = WS_LSE + 6 * MiB, SS_BYTES = 13 * 32768 * 8;
constexpr size_t WS_MEMN = WS_SS + 4 * MiB;
constexpr size_t WS_END = WS_MEMN + 32 * MiB;
static_assert((size_t)INW * DM * 2 == 21 * MiB && (size_t)NGU * DM * 2 == 44 * MiB && (size_t)DM * DFF * 2 == 22 * MiB, "weight map");
static_assert((size_t)M * DFF * 2 == 352 * MiB, "big buffer");
constexpr int CW_TMO = 0;
constexpr int CW_BAR = 4096;
constexpr int RING_OFF = 0, RING_BYTES = 131072;
constexpr int LDSCTL_OFF = RING_BYTES, MISC_OFF = LDSCTL_OFF + 320;
constexpr int LDS_BYTES = 147456;

#define GAS __attribute__((address_space(1)))
#define LAS __attribute__((address_space(3)))
typedef unsigned short bf16;
typedef unsigned v4u __attribute__((ext_vector_type(4)));
typedef unsigned v2u __attribute__((ext_vector_type(2)));
typedef float f32x4 __attribute__((ext_vector_type(4)));
typedef GAS unsigned gu32;
#define RLX_AGENT __ATOMIC_RELAXED, __HIP_MEMORY_SCOPE_AGENT
#define LDS_WAIT() asm volatile("s_waitcnt lgkmcnt(0)" ::: "memory")
__device__ __forceinline__ unsigned f2bf(float f) { unsigned u = __builtin_bit_cast(unsigned, f); return (u + 0x7fffu + ((u >> 16) & 1u)) >> 16; }
typedef float pk_f32x2 __attribute__((ext_vector_type(2)));
typedef __bf16 pk_bf16x2 __attribute__((ext_vector_type(2)));
__device__ __forceinline__ unsigned pk2(float lo, float hi) { pk_f32x2 v = {lo, hi}; return __builtin_bit_cast(unsigned, __builtin_convertvector(v, pk_bf16x2)); }
__device__ __forceinline__ float bflo(unsigned w) { return __builtin_bit_cast(float, w << 16); }
__device__ __forceinline__ float bfhi(unsigned w) { return __builtin_bit_cast(float, w & 0xffff0000u); }
__device__ __forceinline__ float bf1(bf16 x) { return __builtin_bit_cast(float, (unsigned)x << 16); }
__device__ __forceinline__ float ex2(float x) { return __builtin_amdgcn_exp2f(x); }
#define XB_TMO      128
#define XB_XCNT(j)  (256  + 64 * (j))
#define XB_XSUB(j)  (1280 + 64 * (j))
#define XB_XGEN(j)  (2304 + 64 * (j))
#define XB_TOP      3328
#define XB_TOPGEN   3392
#define XCD_BAR_WORDS 3456
#define XB_SPIN_CAP (1u << 18)

__device__ __forceinline__ unsigned xb_ld(unsigned* p)              { return __hip_atomic_load(p, __ATOMIC_RELAXED, __HIP_MEMORY_SCOPE_AGENT); }
__device__ __forceinline__ unsigned xb_add(unsigned* p, unsigned v) { return __hip_atomic_fetch_add(p, v, __ATOMIC_RELAXED, __HIP_MEMORY_SCOPE_AGENT); }
__device__ __forceinline__ unsigned xb_xcc_id() { return (unsigned)__builtin_amdgcn_s_getreg((3 << 11) | 20) & 0xFu; }
#define XB_SPIN(cond, bar) do { unsigned _sp = 0; while (cond) { __builtin_amdgcn_s_sleep(1); \
    if ((++_sp & 255u) == 0u) { if (xb_ld(&(bar)[XB_TMO])) break; if (_sp > XB_SPIN_CAP) { atomicAdd(&(bar)[XB_TMO], 1u); break; } } } } while (0)

struct XcdBarrier {
    unsigned* bar; unsigned x;
    volatile LAS unsigned* st;
};

__device__ __forceinline__ XcdBarrier xcd_barrier_post(unsigned* bar, volatile LAS unsigned* st) {
    XcdBarrier b; b.bar = bar; b.x = xb_xcc_id(); b.st = st;
    if (threadIdx.x == 0) (void)xb_add(&bar[XB_XCNT(b.x)], 1u);
    return b;
}
__device__ __forceinline__ void xcd_barrier_complete(unsigned* bar, unsigned x, unsigned& nloc, unsigned& nx) {
    const unsigned G = gridDim.x * gridDim.y * gridDim.z;
    unsigned sum, cnt, mine, sp = 0u;
    for (;;) {
        sum = 0u; cnt = 0u; mine = 0u;
#pragma unroll
        for (unsigned j = 0; j < 16; ++j) { const unsigned c = xb_ld(&bar[XB_XCNT(j)]); sum += c; cnt += (c > 0u) ? 1u : 0u; mine = (j == x) ? c : mine; }
        if (sum == G) break;
        __builtin_amdgcn_s_sleep(1);
        if ((++sp & 255u) == 0u) { if (xb_ld(&bar[XB_TMO])) break; if (sp > XB_SPIN_CAP) { atomicAdd(&bar[XB_TMO], 1u); break; } }
    }
    nloc = mine > 0u ? mine : 1u; nx = cnt > 0u ? cnt : 1u;
}

__device__ __forceinline__ void xcd_barrier(const XcdBarrier& b) {
    asm volatile("s_waitcnt vmcnt(0)" ::: "memory");
    __syncthreads();
    if (threadIdx.x == 0) {
        unsigned* bar = b.bar;
        __builtin_amdgcn_s_waitcnt(0);
        unsigned nloc = b.st[0], nx = b.st[1];
        if (nloc == 0u) { xcd_barrier_complete(bar, b.x, nloc, nx); b.st[0] = nloc; b.st[1] = nx; }
        const unsigned old = xb_add(&bar[XB_XSUB(b.x)], 1u);
        const unsigned gen = old / nloc;
        if (old + 1u == (gen + 1u) * nloc) {
            __builtin_amdgcn_fence(__ATOMIC_RELEASE, "agent");
            asm volatile("s_waitcnt vmcnt(0)" ::: "memory");
            const unsigned og = xb_add(&bar[XB_TOP], 1u);
            const unsigned tg = og / nx;
            if (og + 1u == (tg + 1u) * nx) xb_add(&bar[XB_TOPGEN], 1u);
            else XB_SPIN(xb_ld(&bar[XB_TOPGEN]) == tg, bar);
            __builtin_amdgcn_fence(__ATOMIC_ACQUIRE, "agent");
            xb_add(&bar[XB_XGEN(b.x)], 1u);
            asm volatile("s_waitcnt vmcnt(0)" ::: "memory");
        } else {
            XB_SPIN(xb_ld(&bar[XB_XGEN(b.x)]) == gen, bar);
            __builtin_amdgcn_fence(__ATOMIC_ACQUIRE, "agent");
            asm volatile("s_waitcnt vmcnt(0)" ::: "memory");
        }
    }
    __syncthreads();
}

__device__ __forceinline__ unsigned xcd_barrier_post_rank(unsigned* bar, unsigned x) { return xb_add(&bar[XB_XCNT(x)], 1u); }
__device__ __forceinline__ void xcd_barrier2(const XcdBarrier& b, const bool team) {
    asm volatile("s_waitcnt vmcnt(0)" ::: "memory");
    __syncthreads();
    if (threadIdx.x == 0) {
        unsigned* bar = b.bar;
        __builtin_amdgcn_s_waitcnt(0);
        unsigned nloc = b.st[0], nx = b.st[1];
        if (nloc == 0u) { xcd_barrier_complete(bar, b.x, nloc, nx); b.st[0] = nloc; b.st[1] = nx; }
        const unsigned old = xb_add(&bar[XB_XSUB(b.x)], 1u);
        const unsigned gen = old / nloc;
        if (old + 1u == (gen + 1u) * nloc) {
            if (!team) {
                __builtin_amdgcn_fence(__ATOMIC_RELEASE, "agent");
                asm volatile("s_waitcnt vmcnt(0)" ::: "memory");
                const unsigned og = xb_add(&bar[XB_TOP], 1u);
                const unsigned tg = og / nx;
                if (og + 1u == (tg + 1u) * nx) xb_add(&bar[XB_TOPGEN], 1u);
                else XB_SPIN(xb_ld(&bar[XB_TOPGEN]) == tg, bar);
            }
            __builtin_amdgcn_fence(__ATOMIC_ACQUIRE, "agent");
            xb_add(&bar[XB_XGEN(b.x)], 1u);
            asm volatile("s_waitcnt vmcnt(0)" ::: "memory");
        } else {
            XB_SPIN(xb_ld(&bar[XB_XGEN(b.x)]) == gen, bar);
            __builtin_amdgcn_fence(__ATOMIC_ACQUIRE, "agent");
            asm volatile("s_waitcnt vmcnt(0)" ::: "memory");
        }
    }
    __syncthreads();
}

__device__ __forceinline__ float wave_sum(float v) {
    return sum_x32(sum_x16(sum_row16(v)));
}
typedef short tr_v4i16 __attribute__((ext_vector_type(4)));
struct TItem { const float* W; int K, N; bf16* WT; int dst_row0, k0, n0; const float* gk; };
__device__ __forceinline__ void ti_load(const TItem& t, f32x4 (&w)[16], float (&gv)[16], int lane) {
    const int i16 = lane & 15, g = lane >> 4;
#pragma unroll
    for (int i = 0; i < 16; ++i) w[i] = __builtin_nontemporal_load((const GAS f32x4*)(t.W + (size_t)(t.k0 + 4 * i + g) * t.N + t.n0 + 4 * i16));
#pragma unroll
    for (int i = 0; i < 16; ++i) gv[i] = t.gk ? t.gk[t.k0 + 4 * i + g] : 1.f;
}
__device__ __forceinline__ void ti_finish(const TItem& t, const f32x4 (&w)[16], const float (&gv)[16], LAS char* scr, int lane) {
    const int i16 = lane & 15, g = lane >> 4;
#pragma unroll
    for (int i = 0; i < 16; ++i) { const int kk = 4 * i + g; const f32x4 x = w[i] * gv[i];
        v2u p; p.x = pk2(x.x, x.y); p.y = pk2(x.z, x.w); *(LAS v2u*)(scr + kk * 144 + i16 * 8) = p; }
    LDS_WAIT(); asm volatile("" ::: "memory");
    const int q = i16 >> 2, pp = i16 & 3;
#pragma unroll
    for (int p = 0; p < 8; ++p) { const int c8 = (p & 1) * 4 + g, nb = p >> 1;
        LAS const char* src = scr + (8 * c8 + q) * 144 + nb * 32 + pp * 8;
        const tr_v4i16 lo = __builtin_amdgcn_ds_read_tr16_b64_v4i16((LAS tr_v4i16*)src), hi = __builtin_amdgcn_ds_read_tr16_b64_v4i16((LAS tr_v4i16*)(src + 4 * 144));
        v4u o; const v2u l2 = __builtin_bit_cast(v2u, lo), h2 = __builtin_bit_cast(v2u, hi); o.x = l2.x; o.y = l2.y; o.z = h2.x; o.w = h2.y;
        *(GAS v4u*)(t.WT + (size_t)(t.dst_row0 + nb * 16 + i16) * t.K + t.k0 + 8 * c8) = o; }
    LDS_WAIT(); asm volatile("" ::: "memory");
}
__device__ __forceinline__ float row_load_ss(const float* xrow, int lane, f32x4 (&v)[8]) {
    const GAS f32x4* xr = (const GAS f32x4*)xrow + lane; float s = 0.f;
#pragma unroll
    for (int j = 0; j < 8; ++j) { v[j] = xr[64 * j]; s += (v[j].x * v[j].x + v[j].y * v[j].y) + (v[j].z * v[j].z + v[j].w * v[j].w); }
    return wave_sum(s);
}
__device__ __forceinline__ void row_store_bf16(bf16* orow, int lane, const f32x4 (&v)[8], const f32x4 (&g)[8], float rstd) {
    GAS unsigned long long* o8 = (GAS unsigned long long*)orow + lane;
#pragma unroll
    for (int j = 0; j < 8; ++j) o8[64 * j] = (unsigned long long)pk2(v[j].x * rstd * g[j].x, v[j].y * rstd * g[j].y) | ((unsigned long long)pk2(v[j].z * rstd * g[j].z, v[j].w * rstd * g[j].w) << 32);
}
__device__ __forceinline__ void load_gain(const float* g, int lane, f32x4 (&gv)[8]) {
    const GAS f32x4* gr = (const GAS f32x4*)g + lane;
#pragma unroll
    for (int j = 0; j < 8; ++j) gv[j] = gr[64 * j];
}
__device__ __forceinline__ void norm_rows_phase(const float* X, const float* g, bf16* XN, int gw, int NGW, int lane) {
    f32x4 gv[8]; load_gain(g, lane, gv);
    for (int m = gw; m < M; m += NGW) { f32x4 v[8]; const float ss = row_load_ss(X + (size_t)m * DM, lane, v);
        const float rstd = 1.f / sqrtf(ss * (1.f / DM) + EPS); row_store_bf16(XN + (size_t)m * DM, lane, v, gv, rstd); }
}

struct Ptrs {
    const float *x, *mem, *norm_mix, *w_in, *sinks, *gain_a, *gain_b, *gain_c, *w_out, *norm_xattn, *norm_mem, *wq_x, *wk_x, *wv_x, *wo_x, *norm_ffn, *w_gate, *w_up, *w_down, *norm_final;
};
constexpr int IT_IN = 32 * 84, IT_OUT = 32 * 32, IT_Q = 32 * 8, IT_O = 8 * 32, IT_G = 32 * 88, IT_DN = 88 * 32;
constexpr int IT_LAYER = IT_IN + IT_OUT + 3 * IT_Q + IT_O + 2 * IT_G + IT_DN;
__device__ __forceinline__ TItem p0_item(const Ptrs& P, unsigned char* ws, int it) {
        const int l = it / IT_LAYER; int r = it % IT_LAYER;
        unsigned char* wl = ws + WS_WL + (size_t)l * WL_STRIDE;
        if (r < IT_IN) { return TItem{P.w_in + (size_t)l * DM * INW, DM, INW, (bf16*)(wl + WL_IN), (r % 84) * 64, (r / 84) * 64, (r % 84) * 64, P.norm_mix + l * DM}; } r -= IT_IN;
        if (r < IT_OUT) { return TItem{P.w_out + (size_t)l * DM * DM, DM, DM, (bf16*)(wl + WL_OUT), (r % 32) * 64, (r / 32) * 64, (r % 32) * 64, nullptr}; } r -= IT_OUT;
        if (r < IT_Q) { return TItem{P.wq_x + (size_t)l * DM * XW, DM, XW, (bf16*)(wl + WL_Q), (r % 8) * 64, (r / 8) * 64, (r % 8) * 64, P.norm_xattn + l * DM}; } r -= IT_Q;
        if (r < IT_Q) { return TItem{P.wk_x + (size_t)l * DM * XW, DM, XW, (bf16*)(ws + WS_WKV) + (size_t)l * 1024 * DM, (r % 8) * 64, (r / 8) * 64, (r % 8) * 64, nullptr}; } r -= IT_Q;
        if (r < IT_Q) { return TItem{P.wv_x + (size_t)l * DM * XW, DM, XW, (bf16*)(ws + WS_WKV) + (size_t)l * 1024 * DM, 512 + (r % 8) * 64, (r / 8) * 64, (r % 8) * 64, nullptr}; } r -= IT_Q;
        if (r < IT_O) { return TItem{P.wo_x + (size_t)l * XW * DM, XW, DM, (bf16*)(wl + WL_O), (r % 32) * 64, (r / 32) * 64, (r % 32) * 64, nullptr}; } r -= IT_O;
        if (r < IT_G) { const int n0 = (r % 88) * 64; return TItem{P.w_gate + (size_t)l * DM * DFF, DM, DFF, (bf16*)(wl + WL_GU), 256 * (n0 >> 7) + (n0 & 127), (r / 88) * 64, n0, P.norm_ffn + l * DM}; } r -= IT_G;
        if (r < IT_G) { const int n0 = (r % 88) * 64; return TItem{P.w_up + (size_t)l * DM * DFF, DM, DFF, (bf16*)(wl + WL_GU), 256 * (n0 >> 7) + 128 + (n0 & 127), (r / 88) * 64, n0, P.norm_ffn + l * DM}; } r -= IT_G;
        return TItem{P.w_down + (size_t)l * DFF * DM, DFF, DM, (bf16*)(wl + WL_DN), (r % 32) * 64, (r / 32) * 64, (r % 32) * 64, nullptr};
}
__device__ __forceinline__ void p0_convert(const Ptrs& P, unsigned char* ws, bf16* H16, LAS char* scr, int gw, int NGW, int lane) {
    { const int TOT = DEPTH * IT_LAYER; int it = gw;
      if (it < TOT) { TItem A = p0_item(P, ws, it), B = A; f32x4 wa[16], wb[16]; float ga[16], gb[16];
        ti_load(A, wa, ga, lane);
        for (;;) {
            const int nb = it + NGW; const bool hb = nb < TOT; if (hb) { B = p0_item(P, ws, nb); ti_load(B, wb, gb, lane); }
            ti_finish(A, wa, ga, scr, lane);
            if (!hb) break;
            const int na = nb + NGW; const bool ha = na < TOT; if (ha) { A = p0_item(P, ws, na); ti_load(A, wa, ga, lane); }
            ti_finish(B, wb, gb, scr, lane);
            if (!ha) break;
            it = na; } } }
    for (int m = gw; m < MROWS; m += NGW) { f32x4 v[8]; const float ss = row_load_ss(P.mem + (size_t)m * DM, lane, v); const float rstd = 1.f / sqrtf(ss * (1.f / DM) + EPS);
        for (int l = 0; l < DEPTH; ++l) { f32x4 gv[8]; load_gain(P.norm_mem + l * DM, lane, gv); row_store_bf16((bf16*)(ws + WS_MEMN) + ((size_t)l * MROWS + m) * DM, lane, v, gv, rstd); } }
    { unsigned long long* ss0 = (unsigned long long*)(ws + WS_SS); f32x4 one[8];
#pragma unroll
      for (int j = 0; j < 8; ++j) one[j] = (f32x4){1.f, 1.f, 1.f, 1.f};
      for (int m = gw; m < M; m += 2 * NGW) { f32x4 v[2][8];
#pragma unroll
          for (int q = 0; q < 2; ++q) { const GAS f32x4* xr = (const GAS f32x4*)(P.x + (size_t)(m + q * NGW) * DM) + lane;
#pragma unroll
              for (int j = 0; j < 8; ++j) v[q][j] = xr[64 * j]; }
#pragma unroll
          for (int q = 0; q < 2; ++q) { const int mq = m + q * NGW; float s = 0.f;
#pragma unroll
              for (int j = 0; j < 8; ++j) s += (v[q][j].x * v[q][j].x + v[q][j].y * v[q][j].y) + (v[q][j].z * v[q][j].z + v[q][j].w * v[q][j].w);
              const float ss = wave_sum(s); row_store_bf16(H16 + (size_t)mq * DM, lane, v[q], one, 1.f);
              if (lane == 0) { const unsigned hi_ = (unsigned)ss, lo_ = (unsigned)((ss - (float)hi_) * 4294967296.f); ss0[mq] = ((unsigned long long)hi_ << 32) | lo_; } } } }
}

__device__ __forceinline__ void kmean_phase(const bf16* PJ, float* KM, int gw, int NGW, int lane) {
    for (int it = gw; it < (M / 256) * 8; it += NGW) { const int pm = it >> 3, h = it & 7; const bf16* p = PJ + (size_t)pm * 256 * INW + KB + h * 64 + lane; float s = 0.f;
#pragma unroll 8
        for (int r = 0; r < 256; ++r) s += bf1(p[(size_t)r * INW]);
        KM[pm * 512 + h * 64 + lane] = s; }
}

__device__ __forceinline__ float dot8(v4u a, v4u b, float acc) {
    acc = fmaf(bflo(a.x), bflo(b.x), acc); acc = fmaf(bfhi(a.x), bfhi(b.x), acc); acc = fmaf(bflo(a.y), bflo(b.y), acc); acc = fmaf(bfhi(a.y), bfhi(b.y), acc);
    acc = fmaf(bflo(a.z), bflo(b.z), acc); acc = fmaf(bfhi(a.z), bfhi(b.z), acc); acc = fmaf(bflo(a.w), bflo(b.w), acc); acc = fmaf(bfhi(a.w), bfhi(b.w), acc); return acc;
}
struct Soft64 { float m, l; float o[64]; };
#define SOFT64_KEY(S, sc_, vrow_) do { const float _sc = (sc_); if (_sc > S.m) { const float _a = ex2(S.m - _sc); S.l *= _a; _Pragma("unroll") for (int _d = 0; _d < 64; ++_d) S.o[_d] *= _a; S.m = _sc; } \
    const float _p = ex2(_sc - S.m); S.l += _p; const GAS v4u* _v = (const GAS v4u*)(vrow_); \
    _Pragma("unroll") for (int _i = 0; _i < 8; ++_i) { const v4u _w = _v[_i]; S.o[8 * _i + 0] = fmaf(_p, bflo(_w.x), S.o[8 * _i + 0]); S.o[8 * _i + 1] = fmaf(_p, bfhi(_w.x), S.o[8 * _i + 1]); \
        S.o[8 * _i + 2] = fmaf(_p, bflo(_w.y), S.o[8 * _i + 2]); S.o[8 * _i + 3] = fmaf(_p, bfhi(_w.y), S.o[8 * _i + 3]); S.o[8 * _i + 4] = fmaf(_p, bflo(_w.z), S.o[8 * _i + 4]); S.o[8 * _i + 5] = fmaf(_p, bfhi(_w.z), S.o[8 * _i + 5]); \
        S.o[8 * _i + 6] = fmaf(_p, bflo(_w.w), S.o[8 * _i + 6]); S.o[8 * _i + 7] = fmaf(_p, bfhi(_w.w), S.o[8 * _i + 7]); } } while (0)
#define QK64(qw_, krow_, out_) do { const GAS v4u* _k = (const GAS v4u*)(krow_); float _a0 = 0.f, _a1 = 0.f; _Pragma("unroll") for (int _i = 0; _i < 8; _i += 2) { _a0 = dot8(qw_[_i], _k[_i], _a0); _a1 = dot8(qw_[_i + 1], _k[_i + 1], _a1); } out_ = _a0 + _a1; } while (0)
#define STORE_O64(S, orow_) do { const float _rl = 1.f / S.l; GAS v4u* _o = (GAS v4u*)(orow_); _Pragma("unroll") for (int _i = 0; _i < 8; ++_i) { v4u _w; _w.x = pk2(S.o[8 * _i] * _rl, S.o[8 * _i + 1] * _rl); _w.y = pk2(S.o[8 * _i + 2] * _rl, S.o[8 * _i + 3] * _rl); \
        _w.z = pk2(S.o[8 * _i + 4] * _rl, S.o[8 * _i + 5] * _rl); _w.w = pk2(S.o[8 * _i + 6] * _rl, S.o[8 * _i + 7] * _rl); _o[_i] = _w; } } while (0)

__device__ __forceinline__ void naive_attn_a(const bf16* PJ, const float* sinks, bf16* O, int gtid, int nthr) {
    for (int it = gtid; it < 8 * M; it += nthr) { const int h = it / M, m = it % M, t = m & (SEQ - 1), kvh = h >> 2;
        v4u qw[8]; { const GAS v4u* q = (const GAS v4u*)(PJ + (size_t)m * INW + QA + h * 64);
#pragma unroll
            for (int i = 0; i < 8; ++i) qw[i] = q[i]; }
        const float slope2 = ex2(-(float)(h + 1)) * LOG2E;
        Soft64 S; S.m = sinks[h] * LOG2E; S.l = 1.f;
#pragma unroll
        for (int d = 0; d < 64; ++d) S.o[d] = 0.f;
        const int nk = t < 127 ? t + 1 : 128;
        for (int dist = 0; dist < nk; ++dist) { const bf16* kr = PJ + (size_t)(m - dist) * INW + KA + kvh * 64; float sc; QK64(qw, kr, sc); sc -= slope2 * (float)dist;
            SOFT64_KEY(S, sc, kr + (VA - KA)); }
        STORE_O64(S, O + (size_t)m * DM + h * 64); }
}
__device__ __forceinline__ void naive_attn_b(const bf16* PJ, const float* KM, bf16* O, int gtid, int nthr) {
    for (int it = gtid; it < 8 * M; it += nthr) { const int h = it / M, m = it % M, t = m & (SEQ - 1), blk = t >> 8, pm0 = (m >> 12) << 4;
        v4u qw[8]; { const GAS v4u* q = (const GAS v4u*)(PJ + (size_t)m * INW + QB + h * 64);
#pragma unroll
            for (int i = 0; i < 8; ++i) qw[i] = q[i]; }
        const float slope2 = ex2(-(float)(h + 1)) * LOG2E;
        float g1 = -INFINITY, g2 = -INFINITY, g3 = -INFINITY; int i1 = -1, i2 = -1, i3 = -1;
        for (int n = 0; n < blk; ++n) { const GAS f32x4* km = (const GAS f32x4*)(KM + (size_t)(pm0 + n) * 512 + h * 64); float g = 0.f;
#pragma unroll
            for (int i = 0; i < 8; ++i) { const f32x4 a = km[2 * i], b = km[2 * i + 1]; const v4u w = qw[i];
                g = fmaf(bflo(w.x), a.x, g); g = fmaf(bfhi(w.x), a.y, g); g = fmaf(bflo(w.y), a.z, g); g = fmaf(bfhi(w.y), a.w, g);
                g = fmaf(bflo(w.z), b.x, g); g = fmaf(bfhi(w.z), b.y, g); g = fmaf(bflo(w.w), b.z, g); g = fmaf(bfhi(w.w), b.w, g); }
            if (g > g1) { g3 = g2; i3 = i2; g2 = g1; i2 = i1; g1 = g; i1 = n; } else if (g > g2) { g3 = g2; i3 = i2; g2 = g; i2 = n; } else if (g > g3) { g3 = g; i3 = n; } }
        Soft64 S; S.m = -1e30f; S.l = 0.f;
#pragma unroll
        for (int d = 0; d < 64; ++d) S.o[d] = 0.f;
        const int mb = m - t;
        for (int s = 0; s < 4; ++s) { const int n = (s == 0) ? blk : (s == 1 ? i1 : (s == 2 ? i2 : i3)); if (n < 0) continue;
            const int p0 = n * 256, nk = (s == 0) ? (t - p0 + 1) : 256;
            for (int j = 0; j < nk; ++j) { const int pos = p0 + j; const bf16* kr = PJ + (size_t)(mb + pos) * INW + KB + h * 64; float sc; QK64(qw, kr, sc); sc -= slope2 * (float)(t - pos);
                SOFT64_KEY(S, sc, kr + (VB - KB)); } }
        STORE_O64(S, O + (size_t)m * DM + 512 + h * 64); }
}
__device__ __forceinline__ void naive_attn_c(const bf16* PJ, bf16* O, int gtid, int nthr) {
    for (int it = gtid; it < 16 * M; it += nthr) { const int h = it / M, m = it % M, t = m & (SEQ - 1);
        v4u qw[8]; { const GAS v4u* q = (const GAS v4u*)(PJ + (size_t)m * INW + QC + h * 64);
#pragma unroll
            for (int i = 0; i < 8; ++i) qw[i] = q[i]; }
        const float slope2 = ex2(-0.5f * (float)(h + 1)) * LOG2E;
        Soft64 S; S.m = -1e30f; S.l = 0.f;
#pragma unroll
        for (int d = 0; d < 64; ++d) S.o[d] = 0.f;
        for (int br = 0; br < 3; ++br) { const int dd = (br == 0) ? 1 : (br == 1 ? 4 : 16);
            for (int step = 0; step <= 128; ++step) { const int dist = step * dd; if (dist > t) break;
                const bf16* kr = PJ + (size_t)(m - dist) * INW + KC + h * 64; float sc; QK64(qw, kr, sc); sc -= slope2 * (float)dist;
                SOFT64_KEY(S, sc, kr + (VC - KC)); } }
        STORE_O64(S, O + (size_t)m * DM + 1024 + h * 64); }
}
__device__ __forceinline__ void naive_attn_x(const bf16* QX, const bf16* KVX  , bf16* OX, int gtid, int nthr) {
    for (int it = gtid; it < 8 * M; it += nthr) { const int hh = it / M, m = it % M, h = hh >> 1, half = hh & 1, b = m >> 12;
        v4u qw[16]; { const GAS v4u* q = (const GAS v4u*)(QX + (size_t)m * XW + h * 128);
#pragma unroll
            for (int i = 0; i < 16; ++i) qw[i] = q[i]; }
        Soft64 S; S.m = -1e30f; S.l = 0.f;
#pragma unroll
        for (int d = 0; d < 64; ++d) S.o[d] = 0.f;
        for (int j = 0; j < MEML; ++j) { const bf16* kr = KVX + (size_t)(b * MEML + j) * 1024 + h * 128; const GAS v4u* k = (const GAS v4u*)kr; float a0 = 0.f, a1 = 0.f;
#pragma unroll
            for (int i = 0; i < 16; i += 2) { a0 = dot8(qw[i], k[i], a0); a1 = dot8(qw[i + 1], k[i + 1], a1); }
            SOFT64_KEY(S, a0 + a1, kr + 512 + half * 64); }
        STORE_O64(S, OX + (size_t)m * XW + h * 128 + half * 64); }
}
template <bool MERGE>
__device__ __forceinline__ void ynorm_phase(bf16* Y, bf16* YO  , const bf16* PART, const float* LSE, const float* ga, const float* gb, const float* gc, int row_lo, int row_hi, int row_step, int lane) {
    f32x4 g[4][2];
#pragma unroll
    for (int j = 0; j < 4; ++j) { const float* gp = (j == 0) ? ga : (j == 1 ? gb : gc + (j - 2) * 512); g[j][0] = *(const GAS f32x4*)(gp + 8 * lane); g[j][1] = *(const GAS f32x4*)(gp + 8 * lane + 4); }
    struct YR { v4u w[4], p1[2], p2[2]; float l0[2], l1[2], l2[2]; };
    auto load = [&](YR& R, int m) { GAS v4u* row = (GAS v4u*)(Y + (size_t)m * DM) + lane;
#pragma unroll
        for (int j = 0; j < 4; ++j) R.w[j] = row[64 * j];
        if (MERGE) {
#pragma unroll
            for (int jj = 0; jj < 2; ++jj) { const int hc = 8 * jj + (lane >> 3); R.l0[jj] = LSE[(size_t)m * 16 + hc]; R.l1[jj] = LSE[(size_t)(M + m) * 16 + hc]; R.l2[jj] = LSE[(size_t)(2 * M + m) * 16 + hc];
                R.p1[jj] = *(const GAS v4u*)(PART + (size_t)m * 1024 + 512 * jj + 8 * lane); R.p2[jj] = *(const GAS v4u*)(PART + (size_t)(M + m) * 1024 + 512 * jj + 8 * lane); } } };
    auto finish = [&](const YR& R, int m) { float v[4][8], ss[4];
#pragma unroll
        for (int j = 0; j < 4; ++j) { const v4u w = R.w[j]; v[j][0] = bflo(w.x); v[j][1] = bfhi(w.x); v[j][2] = bflo(w.y); v[j][3] = bfhi(w.y); v[j][4] = bflo(w.z); v[j][5] = bfhi(w.z); v[j][6] = bflo(w.w); v[j][7] = bfhi(w.w);
            if (MERGE && j >= 2) { const float l0 = R.l0[j - 2], l1 = R.l1[j - 2], l2 = R.l2[j - 2];
                const float mx = fmaxf(l0, fmaxf(l1, l2)), e0 = ex2(l0 - mx), e1 = ex2(l1 - mx), e2 = ex2(l2 - mx), ri = 1.f / (e0 + e1 + e2);
                const v4u w1 = R.p1[j - 2], w2 = R.p2[j - 2];
                const float a0 = e0 * ri, a1 = e1 * ri, a2 = e2 * ri;
                v[j][0] = a0 * v[j][0] + a1 * bflo(w1.x) + a2 * bflo(w2.x); v[j][1] = a0 * v[j][1] + a1 * bfhi(w1.x) + a2 * bfhi(w2.x);
                v[j][2] = a0 * v[j][2] + a1 * bflo(w1.y) + a2 * bflo(w2.y); v[j][3] = a0 * v[j][3] + a1 * bfhi(w1.y) + a2 * bfhi(w2.y);
                v[j][4] = a0 * v[j][4] + a1 * bflo(w1.z) + a2 * bflo(w2.z); v[j][5] = a0 * v[j][5] + a1 * bfhi(w1.z) + a2 * bfhi(w2.z);
                v[j][6] = a0 * v[j][6] + a1 * bflo(w1.w) + a2 * bflo(w2.w); v[j][7] = a0 * v[j][7] + a1 * bfhi(w1.w) + a2 * bfhi(w2.w); }
            float s = 0.f;
#pragma unroll
            for (int e = 0; e < 8; ++e) s += v[j][e] * v[j][e];
            ss[j] = wave_sum(s); }
        const float ra = 1.f / sqrtf(ss[0] * (1.f / 512) + EPS), rb = 1.f / sqrtf(ss[1] * (1.f / 512) + EPS), rc = 1.f / sqrtf((ss[2] + ss[3]) * (1.f / 1024) + EPS);
#pragma unroll
        for (int j = 0; j < 4; ++j) { const float r = (j == 0) ? ra : (j == 1 ? rb : rc); v4u w;
            w.x = pk2(v[j][0] * r * g[j][0].x, v[j][1] * r * g[j][0].y); w.y = pk2(v[j][2] * r * g[j][0].z, v[j][3] * r * g[j][0].w);
            w.z = pk2(v[j][4] * r * g[j][1].x, v[j][5] * r * g[j][1].y); w.w = pk2(v[j][6] * r * g[j][1].z, v[j][7] * r * g[j][1].w); ((GAS v4u*)(YO + (size_t)m * DM) + lane)[64 * j] = w; } };
    for (int m = row_lo; m < row_hi; m += 2 * row_step) { YR R[2];
#pragma unroll
        for (int q = 0; q < 2; ++q) if (m + q * row_step < row_hi) load(R[q], m + q * row_step);
#pragma unroll
        for (int q = 0; q < 2; ++q) if (m + q * row_step < row_hi) finish(R[q], m + q * row_step); }
}

namespace att {
typedef float f32x16 __attribute__((ext_vector_type(16)));
typedef float f32x2_t __attribute__((ext_vector_type(2)));
typedef __bf16 bf16x2_t __attribute__((ext_vector_type(2)));
typedef short bf16x8 __attribute__((ext_vector_type(8)));
typedef short s16x4 __attribute__((ext_vector_type(4)));
typedef short v4i16_t __attribute__((ext_vector_type(4)));
#define ATT_MFMA(a, b, c) __builtin_amdgcn_mfma_f32_32x32x16_bf16(a, b, c, 0, 0, 0)
constexpr float THR = 8.f;
constexpr float NEG = -1e30f;
__device__ __forceinline__ unsigned cvtpk(float lo, float hi) { f32x2_t v = {lo, hi}; bf16x2_t b = __builtin_convertvector(v, bf16x2_t); return __builtin_bit_cast(unsigned, b); }
__device__ __forceinline__ s16x4 vtr(LAS const char* p) { return __builtin_bit_cast(s16x4, __builtin_amdgcn_ds_read_tr16_b64_v4i16((LAS v4i16_t*)p)); }
__device__ __forceinline__ float swapmax(float m) { float a, b; swap32(m, a, b); return fmaxf(a, b); }
__device__ __forceinline__ float swapsum(float m) { float a, b; swap32(m, a, b); return a + b; }
__device__ __forceinline__ int crowc(int r) { return (r & 3) + 8 * (r >> 2); }

template <int NKD> struct St { f32x16 o[NKD / 2]; float m, l; };

struct Mask { int on, sgn, thr; };
__device__ __forceinline__ Mask mk_none() { return Mask{0, 1, 0}; }
__device__ __forceinline__ Mask mk_diag() { return Mask{1, -1, 0}; }
__device__ __forceinline__ Mask mk_far(int incl) { return Mask{1, 1, incl ? 0 : 1}; }

template <int NKD>
__device__ __forceinline__ void step(St<NKD>& s, const bf16x8 (&qf)[NKD], const bf16x8 (&kf)[NKD], LAS const char* vimg, const f32x16& kbc, float tb, bool sel, const Mask mk, int r32, int hi) {
    f32x16 S = kbc;
#pragma unroll
    for (int i = 0; i < NKD; ++i) S = ATT_MFMA(kf[i], qf[i], S);
    if (mk.on) { const int sv = mk.sgn * (4 * hi - r32);
#pragma unroll
        for (int r = 0; r < 16; ++r) S[r] = (sv >= mk.thr - mk.sgn * crowc(r)) ? S[r] : NEG; }
    float mx = fmaxf(fmaxf(S[0], S[1]), fmaxf(S[2], S[3]));
#pragma unroll
    for (int r = 4; r < 16; r += 4) mx = fmaxf(mx, fmaxf(fmaxf(S[r], S[r + 1]), fmaxf(S[r + 2], S[r + 3])));
    mx = swapmax(mx);
    const float tmax = sel ? mx + tb : NEG;
    if (__any(tmax > s.m + THR)) { const float mn = fmaxf(s.m, tmax), a = ex2(s.m - mn); s.l *= a; s.m = mn;
#pragma unroll
        for (int c = 0; c < NKD / 2; ++c) s.o[c] *= a; }
    const float cm = sel ? tb - s.m : -INFINITY;
    float ps = 0.f;
#pragma unroll
    for (int r = 0; r < 16; ++r) { S[r] = ex2(S[r] + cm); ps += S[r]; }
    s.l += ps;
    v4u pw0, pw1;
    pw0.x = cvtpk(S[0], S[1]); pw0.y = cvtpk(S[2], S[3]); pw0.z = cvtpk(S[4], S[5]); pw0.w = cvtpk(S[6], S[7]);
    pw1.x = cvtpk(S[8], S[9]); pw1.y = cvtpk(S[10], S[11]); pw1.z = cvtpk(S[12], S[13]); pw1.w = cvtpk(S[14], S[15]);
    const bf16x8 pa0 = __builtin_bit_cast(bf16x8, pw0), pa1 = __builtin_bit_cast(bf16x8, pw1);
#pragma unroll
    for (int c = 0; c < NKD / 2; ++c) {
        const s16x4 a0 = vtr(vimg + c * 2048), a1 = vtr(vimg + c * 2048 + 512), b0 = vtr(vimg + c * 2048 + 1024), b1 = vtr(vimg + c * 2048 + 1536);
        const bf16x8 v0 = {a0[0], a0[1], a0[2], a0[3], a1[0], a1[1], a1[2], a1[3]}, v1 = {b0[0], b0[1], b0[2], b0[3], b1[0], b1[1], b1[2], b1[3]};
        s.o[c] = ATT_MFMA(v0, pa0, s.o[c]); s.o[c] = ATT_MFMA(v1, pa1, s.o[c]); }
}

template <int NKD> __device__ __forceinline__ void load_k(bf16x8 (&kf)[NKD], const bf16* krow) {
#pragma unroll
    for (int i = 0; i < NKD; ++i) kf[i] = *(const GAS bf16x8*)(krow + 16 * i); }
template <int NKD> __device__ __forceinline__ void load_v(v4u (&vr)[NKD], const bf16* vrow  , long rs16  ) {
#pragma unroll
    for (int p = 0; p < NKD; ++p) vr[p] = *(const GAS v4u*)(vrow + (p & 1) * rs16 + (p >> 1) * 32); }
template <int NKD> __device__ __forceinline__ void write_v(const v4u (&vr)[NKD], LAS char* vbuf, int lane) {
#pragma unroll
    for (int p = 0; p < NKD; ++p) *(LAS v4u*)(vbuf + p * 1024 + lane * 16) = vr[p]; }

template <int NKD, bool PREF>
__device__ __forceinline__ void run_tiles(St<NKD>& s, const bf16x8 (&qf)[NKD], const bf16* krow, const bf16* vrow, long rs16, long tstep, int nt, const f32x16& kbc, float tb0, float dtb, bool sel,
                                          const Mask m0, const Mask mfar, LAS char* vl, int lane) {
    const int r32 = lane & 31, hi = lane >> 5;
    const int troff = ((lane >> 4) & 1) * 32 + (lane & 3) * 8 + (4 * hi + ((lane & 15) >> 2)) * 64;
    bf16x8 kf[NKD]; v4u vr[NKD];
    load_k<NKD>(kf, krow); load_v<NKD>(vr, vrow, rs16); write_v<NKD>(vr, vl, lane);
    int buf = 0;
    for (int k = 0; k < nt; ++k) {
        const Mask mk = (k == 0) ? m0 : ((k == 4) ? mfar : mk_none());
        const float tb = tb0 + (float)k * dtb;
        if constexpr (PREF) {
            bf16x8 kn[NKD];
            const bool more = (k + 1 < nt);
            const bf16* kr2 = more ? krow + (long)(k + 1) * tstep : krow; const bf16* vr2 = more ? vrow + (long)(k + 1) * tstep : vrow;
            load_k<NKD>(kn, kr2); load_v<NKD>(vr, vr2, rs16);
            step<NKD>(s, qf, kf, vl + buf * (NKD * 1024) + troff, kbc, tb, sel, mk, r32, hi);
            buf ^= 1; write_v<NKD>(vr, vl + buf * (NKD * 1024), lane);
#pragma unroll
            for (int i = 0; i < NKD; ++i) kf[i] = kn[i];
        } else {
            step<NKD>(s, qf, kf, vl + troff, kbc, tb, sel, mk, r32, hi);
            if (k + 1 < nt) { load_k<NKD>(kf, krow + (long)(k + 1) * tstep); load_v<NKD>(vr, vrow + (long)(k + 1) * tstep, rs16); write_v<NKD>(vr, vl, lane); }
        }
    }
}

template <int NKD> __device__ __forceinline__ void st_init(St<NKD>& s, float m, float l) { s.m = m; s.l = l;
#pragma unroll
    for (int c = 0; c < NKD / 2; ++c)
#pragma unroll
        for (int r = 0; r < 16; ++r) s.o[c][r] = 0.f; }
template <int NKD> __device__ __forceinline__ void st_store(const St<NKD>& s, float rl, bf16* orow  , int hi) {
#pragma unroll
    for (int c = 0; c < NKD / 2; ++c)
#pragma unroll
        for (int g = 0; g < 4; ++g) { v2u w; w.x = cvtpk(s.o[c][4 * g] * rl, s.o[c][4 * g + 1] * rl); w.y = cvtpk(s.o[c][4 * g + 2] * rl, s.o[c][4 * g + 3] * rl);
            *(GAS v2u*)(orow + 32 * c + 8 * g + 4 * hi) = w; }
}
template <int NKD, class RowPtr> __device__ __forceinline__ void st_store_lds(const St<NKD>& s, float rl, LAS char* stg, int lane, RowPtr rowptr) {
    const int r32 = lane & 31, hi = lane >> 5; constexpr int ROWB = NKD * 32;
#pragma unroll
    for (int c = 0; c < NKD / 2; ++c)
#pragma unroll
        for (int g = 0; g < 4; ++g) { v2u w; w.x = cvtpk(s.o[c][4 * g] * rl, s.o[c][4 * g + 1] * rl); w.y = cvtpk(s.o[c][4 * g + 2] * rl, s.o[c][4 * g + 3] * rl);
            *(LAS v2u*)(stg + r32 * ROWB + (((8 * c + 2 * g + hi) ^ (r32 & 15)) << 3)) = w; }
    constexpr int LPR = NKD * 2  , RPP = 64 / LPR  ;
#pragma unroll
    for (int j = 0; j < 32 / RPP; ++j) { const int row = lane / LPR + RPP * j, ch = lane % LPR;
        const v2u a0 = *(const LAS v2u*)(stg + row * ROWB + (((2 * ch) ^ (row & 15)) << 3)), a1 = *(const LAS v2u*)(stg + row * ROWB + (((2 * ch + 1) ^ (row & 15)) << 3));
        v4u w; w.x = a0.x; w.y = a0.y; w.z = a1.x; w.w = a1.y;
        *(GAS v4u*)(rowptr(row) + ch * 8) = w; }
}
template <int NKD> __device__ __forceinline__ void load_q(bf16x8 (&qf)[NKD], const bf16* qrow  ) {
#pragma unroll
    for (int i = 0; i < NKD; ++i) qf[i] = *(const GAS bf16x8*)(qrow + 16 * i); }
__device__ __forceinline__ void make_kbc(f32x16& kbc, float sl  , int hi) {
#pragma unroll
    for (int r = 0; r < 16; ++r) kbc[r] = sl * (float)(crowc(r) + 4 * hi); }

__device__ __forceinline__ void band_item(const bf16* PJ, int brow, int qt0, int dd, int ut, int qcol, int kcol, int vcol, float slope2, int mode, float sink2,
                                          bf16* out  , int opitch, float* lse  , int lpitch, LAS char* vl, int lane) {
    const int r32 = lane & 31, hi = lane >> 5;
    bf16x8 qf[4]; load_q<4>(qf, PJ + (size_t)(brow + qt0 + r32 * dd) * INW + qcol + 8 * hi);
    const float sl = slope2 * (float)dd; f32x16 kbc; make_kbc(kbc, sl, hi);
    St<4> s; if (mode == 0) st_init<4>(s, sink2 + sl * (float)r32, hi == 0 ? 1.f : 0.f); else st_init<4>(s, NEG, 0.f);
    const int nt = (ut + 1 < 5) ? ut + 1 : 5;
    const bf16* t0 = PJ + (size_t)(brow + qt0) * INW;
    const long rs = (long)dd * INW;
    run_tiles<4, true>(s, qf, t0 + (long)r32 * rs + kcol + 8 * hi, t0 + (long)(lane >> 2) * rs + vcol + 8 * (lane & 3), 16 * rs, -32 * rs, nt, kbc, 0.f, -32.f * sl, true, mk_diag(), mk_far(mode), vl, lane);
    const float lt = swapsum(s.l), rl = 1.f / lt;
    st_store<4>(s, rl, out + (size_t)(brow + qt0 + r32 * dd) * opitch, hi);
    if (lse && hi == 0) lse[(size_t)(brow + qt0 + r32 * dd) * lpitch] = s.m + __builtin_amdgcn_logf(lt) - sl * (float)r32;
}

__device__ __forceinline__ void moba_item(const bf16* PJ, const float* KM, int b, int h, int blk, int w, bf16* O, LAS char* vl, int lane) {
    const int r32 = lane & 31, hi = lane >> 5, brow = b * SEQ, q0 = blk * 256 + 32 * w;
    bf16x8 qf[4]; load_q<4>(qf, PJ + (size_t)(brow + q0 + r32) * INW + QB + h * 64 + 8 * hi);
    const float slope2 = ex2(-(float)(h + 1)) * LOG2E; f32x16 kbc; make_kbc(kbc, slope2, hi);
    float g1 = -INFINITY, g2 = -INFINITY, g3 = -INFINITY; int i1 = -1, i2 = -1, i3 = -1;
    for (int n = 0; n < blk; ++n) { const float* km = KM + (size_t)(b * 16 + n) * 512 + h * 64 + 8 * hi; float g = 0.f;
#pragma unroll
        for (int i = 0; i < 4; ++i) { const f32x4 a = *(const GAS f32x4*)(km + 16 * i), c = *(const GAS f32x4*)(km + 16 * i + 4); const v4u wq = __builtin_bit_cast(v4u, qf[i]);
            g = fmaf(bflo(wq.x), a.x, g); g = fmaf(bfhi(wq.x), a.y, g); g = fmaf(bflo(wq.y), a.z, g); g = fmaf(bfhi(wq.y), a.w, g);
            g = fmaf(bflo(wq.z), c.x, g); g = fmaf(bfhi(wq.z), c.y, g); g = fmaf(bflo(wq.w), c.z, g); g = fmaf(bfhi(wq.w), c.w, g); }
        g = swapsum(g);
        if (g > g1) { g3 = g2; i3 = i2; g2 = g1; i2 = i1; g1 = g; i1 = n; } else if (g > g2) { g3 = g2; i3 = i2; g2 = g; i2 = n; } else if (g > g3) { g3 = g; i3 = n; } }
    unsigned selmask = 0u; if (i1 >= 0) selmask |= 1u << i1; if (i2 >= 0) selmask |= 1u << i2; if (i3 >= 0) selmask |= 1u << i3;
    St<4> s; st_init<4>(s, NEG, 0.f);
    const bf16* t0 = PJ + (size_t)(brow + q0) * INW;
    const long rs = INW;
    run_tiles<4, true>(s, qf, t0 + (long)r32 * rs + KB + h * 64 + 8 * hi, t0 + (long)(lane >> 2) * rs + VB + h * 64 + 8 * (lane & 3), 16 * rs, -32 * rs, w + 1, kbc, 0.f, -32.f * slope2, true, mk_diag(), mk_none(), vl, lane);
    for (int n = blk - 1; n >= 0; --n) { const bool sel = (selmask >> n) & 1u; if (!__any(sel)) continue;
        const long off = (long)((n - blk) * 256 + 224 - 32 * w) * rs;
        run_tiles<4, true>(s, qf, t0 + off + (long)r32 * rs + KB + h * 64 + 8 * hi, t0 + off + (long)(lane >> 2) * rs + VB + h * 64 + 8 * (lane & 3), 16 * rs, -32 * rs, 8, kbc,
                           slope2 * (float)((n - blk) * 256 + 224 - 32 * w), -32.f * slope2, sel, mk_none(), mk_none(), vl, lane); }
    const float rl = 1.f / swapsum(s.l);
    st_store<4>(s, rl, O + (size_t)(brow + q0 + r32) * DM + 512 + h * 64, hi);
}

__device__ __forceinline__ void xattn_item(const bf16* QX, const bf16* KVX  , int b, int h, int qt, bf16* OX, LAS char* vl, int lane) {
    const int r32 = lane & 31, hi = lane >> 5;
    bf16x8 qf[8]; load_q<8>(qf, QX + (size_t)(b * SEQ + qt * 32 + r32) * XW + h * 128 + 8 * hi);
    f32x16 kbc;
#pragma unroll
    for (int r = 0; r < 16; ++r) kbc[r] = 0.f;
    St<8> s; st_init<8>(s, NEG, 0.f);
    const bf16* t0 = KVX + (size_t)(b * MEML) * 1024 + h * 128;
    run_tiles<8, false>(s, qf, t0 + (long)r32 * 1024 + 8 * hi, t0 + (long)(lane >> 2) * 1024 + 512 + 8 * (lane & 3), 16 * 1024, 32 * 1024, 8, kbc, 0.f, 0.f, true, mk_none(), mk_none(), vl, lane);
    const float rl = 1.f / swapsum(s.l);
    bf16* ob = OX + (size_t)(b * SEQ + qt * 32) * XW + h * 128;
    st_store_lds<8>(s, rl, vl + 8192, lane, [&](int row) { return ob + (size_t)row * XW; });
}
}

__device__ __forceinline__ void mix_b_phase(const bf16* PJ, const float* KM, bf16* O, LAS char* vl, int vcu, int wave, int lane) {
    for (int pi = 0; pi < 2; ++pi) { const int p = vcu * 2 + pi, b = p >> 6, h = (p >> 3) & 7, pr = p & 7;
        att::moba_item(PJ, KM, b, h, 15 - pr, wave, O, vl, lane);
        att::moba_item(PJ, KM, b, h, pr, wave, O, vl, lane); }
}
__device__ __forceinline__ void mix_c_phase(const bf16* PJ, bf16* O, bf16* PART, float* LSE, LAS char* vl, int vcu, int wave, int lane) {
    for (int k = 0; k < 24; ++k) { const int idx = (vcu * 24 + k) * 8 + wave, pat = idx >> 14, rem = idx & 16383, b = rem >> 11, h = (rem >> 7) & 15, qt = rem & 127;
        const int dd = (pat == 0) ? 1 : (pat == 1 ? 4 : 16), tpr = 128 / dd  , r = qt / tpr, ut = qt % tpr;
        const float slope2 = ex2(-0.5f * (float)(h + 1)) * LOG2E;
        bf16* out = (pat == 0) ? O + 1024 + h * 64 : PART + (size_t)(pat - 1) * M * 1024 + h * 64;
        att::band_item(PJ, b * SEQ, ut * 32 * dd + r, dd, ut, QC + h * 64, KC + h * 64, VC + h * 64, slope2, 1, 0.f, out, (pat == 0) ? DM : 1024, LSE + (size_t)pat * M * 16 + h, 16, vl, lane); }
}
__device__ __forceinline__ void mix_a_phase(const bf16* PJ, const float* sinks, bf16* O, LAS char* vl, int vcu, int wave, int lane) {
    for (int k = 0; k < 4; ++k) { const int au = vcu * 4 + k, b = au >> 7, kvh = (au >> 6) & 1, chunk = au & 63, h = kvh * 4 + (wave >> 1), qt = chunk * 2 + (wave & 1);
        const float slope2 = ex2(-(float)(h + 1)) * LOG2E;
        att::band_item(PJ, b * SEQ, qt * 32, 1, qt, QA + h * 64, KA + kvh * 64, VA + kvh * 64, slope2, 0, sinks[h] * LOG2E, O + h * 64, DM, nullptr, 0, vl, lane); }
}
__device__ __forceinline__ void mix_x_phase(const bf16* QX, const bf16* KVX, bf16* OX, LAS char* vl, int vcu, int wave, int lane) {
    for (int k = 0; k < 2; ++k) { const int idx = (vcu * 2 + k) * 8 + wave, b = idx >> 9, h = (idx >> 7) & 3, qt = idx & 127;
        att::xattn_item(QX, KVX, b, h, qt, OX, vl, lane); }
}

namespace att2 {
using namespace att;
constexpr int KIMG = 0, VIMG = 49152;
constexpr int MBUF = 65536, MV = 32768;
constexpr int KMS = RING_BYTES + 1024;
#define ATT2_BAR() asm volatile("s_waitcnt lgkmcnt(0)\n\ts_barrier" ::: "memory")

__device__ __forceinline__ int k_lds_off(int row  , int ch) { return row * 128 + ((ch ^ ((row >> 1) & 7)) << 4); }
__device__ __forceinline__ int v_lds_off(int row, int ch8) { return (ch8 >> 2) * 2048 + row * 64 + (ch8 & 3) * 16; }

__device__ __forceinline__ void lds_k(bf16x8 (&kf)[4], LAS const char* ktile, const int (&koff)[4]) {
#pragma unroll
    for (int i = 0; i < 4; ++i) kf[i] = *(const LAS bf16x8*)(ktile + koff[i]); }

__device__ __forceinline__ int imax3(int a, int b, int c) { return max(max(a, b), c); }
template <bool FIRST>
__device__ __forceinline__ void step2(St<4>& s, f32x16& L, const bf16x8 (&qf)[4], LAS const char* ktile, const int (&koff)[4], LAS const char* vimg, float sl, float tb, bool sel, const Mask mk, int r32, int hi) {
    bf16x8 kf[4]; lds_k(kf, ktile, koff);
    s16x4 va[8];
#pragma unroll
    for (int c = 0; c < 2; ++c) { va[4 * c] = vtr(vimg + c * 2048); va[4 * c + 1] = vtr(vimg + c * 2048 + 512); va[4 * c + 2] = vtr(vimg + c * 2048 + 1024); va[4 * c + 3] = vtr(vimg + c * 2048 + 1536); }
    __builtin_amdgcn_sched_barrier(0);
    f32x16 S; { float slo = sl; asm volatile("" : "+v"(slo));
      float base = fmaf(slo, (float)(4 * hi), tb); if (!FIRST) base = sel ? base - s.m : -INFINITY;
#pragma unroll
      for (int r = 0; r < 16; ++r) S[r] = fmaf(slo, (float)crowc(r), base); }
#pragma unroll
    for (int i = 0; i < 4; ++i) S = ATT_MFMA(kf[i], qf[i], S);
    if (mk.on) { const int sv = mk.sgn * (4 * hi - r32);
#pragma unroll
        for (int r = 0; r < 16; ++r) S[r] = (sv >= mk.thr - mk.sgn * crowc(r)) ? S[r] : NEG; }
    if (FIRST) {
        float mx = fmaxf(fmaxf(S[0], S[1]), fmaxf(S[2], S[3]));
#pragma unroll
        for (int r = 4; r < 16; r += 4) mx = fmaxf(mx, fmaxf(fmaxf(S[r], S[r + 1]), fmaxf(S[r + 2], S[r + 3])));
        mx = swapmax(mx);
        if (__any(mx > s.m + THR)) { const float mn = fmaxf(s.m, mx), a = ex2(s.m - mn); L *= a; s.m = mn; s.o[0] *= a; s.o[1] *= a; }
        const float cm = -s.m;
#pragma unroll
        for (int r = 0; r < 16; ++r) S[r] += cm;
    } else {
        int mb = imax3(__float_as_int(S[0]), __float_as_int(S[1]), __float_as_int(S[2]));
#pragma unroll
        for (int r = 3; r < 15; r += 2) mb = imax3(mb, __float_as_int(S[r]), __float_as_int(S[r + 1]));
        mb = max(mb, __float_as_int(S[15]));
        if (__any(__int_as_float(mb) > THR)) {
            float mx = fmaxf(fmaxf(S[0], S[1]), fmaxf(S[2], S[3]));
#pragma unroll
            for (int r = 4; r < 16; r += 4) mx = fmaxf(mx, fmaxf(fmaxf(S[r], S[r + 1]), fmaxf(S[r + 2], S[r + 3])));
            mx = swapmax(mx);
            const float d = fmaxf(mx, 0.f), a = ex2(-d); s.m += d; L *= a; s.o[0] *= a; s.o[1] *= a;
#pragma unroll
            for (int r = 0; r < 16; ++r) S[r] -= d; }
    }
#pragma unroll
    for (int r = 0; r < 16; ++r) S[r] = ex2(S[r]);
    v4u pw0, pw1;
    pw0.x = cvtpk(S[0], S[1]); pw0.y = cvtpk(S[2], S[3]); pw0.z = cvtpk(S[4], S[5]); pw0.w = cvtpk(S[6], S[7]);
    pw1.x = cvtpk(S[8], S[9]); pw1.y = cvtpk(S[10], S[11]); pw1.z = cvtpk(S[12], S[13]); pw1.w = cvtpk(S[14], S[15]);
    const bf16x8 pa0 = __builtin_bit_cast(bf16x8, pw0), pa1 = __builtin_bit_cast(bf16x8, pw1);
    { const v4u o1 = {0x3f803f80u, 0x3f803f80u, 0x3f803f80u, 0x3f803f80u}; const bf16x8 ones = __builtin_bit_cast(bf16x8, o1); L = ATT_MFMA(ones, pa0, L); L = ATT_MFMA(ones, pa1, L); }
#pragma unroll
    for (int c = 0; c < 2; ++c) {
        const bf16x8 v0 = {va[4 * c][0], va[4 * c][1], va[4 * c][2], va[4 * c][3], va[4 * c + 1][0], va[4 * c + 1][1], va[4 * c + 1][2], va[4 * c + 1][3]};
        const bf16x8 v1 = {va[4 * c + 2][0], va[4 * c + 2][1], va[4 * c + 2][2], va[4 * c + 2][3], va[4 * c + 3][0], va[4 * c + 3][1], va[4 * c + 3][2], va[4 * c + 3][3]};
        s.o[c] = ATT_MFMA(v0, pa0, s.o[c]); s.o[c] = ATT_MFMA(v1, pa1, s.o[c]); }
}

struct BandJob { const bf16* row0; int dd, U0, T; int kcol, vcol; };
template <int NP, int VOFF>
__device__ __forceinline__ void band_prefetch(v4u (&kp)[6], v4u (&vp)[6], const BandJob& J, int tid) {
    const bf16* base = J.row0 + J.kcol; const unsigned rp = (unsigned)(J.dd * INW * 2);
#pragma unroll
    for (int j = 0; j < NP; ++j) { int pos = J.U0 - 128 + (tid >> 3) + 64 * j; pos = pos < 0 ? 0 : pos;
        const unsigned off = (unsigned)pos * rp + (unsigned)((tid & 7) * 16);
        asm volatile("global_load_dwordx4 %0, %1, %2" : "=v"(kp[j]) : "v"(off), "s"(base) : "memory");
        asm volatile("global_load_dwordx4 %0, %1, %2 offset:%3" : "=v"(vp[j]) : "v"(off), "s"(base), "n"(VOFF) : "memory"); }
}
template <int NP, int N>
__device__ __forceinline__ void band_wait(v4u (&kp)[6], v4u (&vp)[6]) {
    __builtin_amdgcn_s_waitcnt(0x0F70 | N);
#pragma unroll
    for (int j = 0; j < NP; ++j) asm volatile("" : "+v"(kp[j]), "+v"(vp[j]));
}
template <int NP>
__device__ __forceinline__ void band_write(const v4u (&kp)[6], const v4u (&vp)[6], LAS char* lds, int tid) {
#pragma unroll
    for (int j = 0; j < NP; ++j) { const int row = (tid >> 3) + 64 * j, t = row >> 5, r = row & 31;
        *(LAS v4u*)(lds + KIMG + t * 4096 + k_lds_off(r, tid & 7)) = kp[j];
        *(LAS v4u*)(lds + VIMG + t * 4096 + v_lds_off(r, tid & 7)) = vp[j]; }
}
__device__ __forceinline__ void band_compute(const BandJob& J, int qi, const bf16x8 (&qf)[4], float slope2, int mode, float sink2, bf16* out, int opitch, float* lse, int lpitch, LAS char* lds, LAS char* stg, int lane) {
    const int r32 = lane & 31, hi = lane >> 5, ut = (J.U0 >> 5) + qi;
    const size_t qoff = (size_t)(J.U0 + 32 * qi + r32) * J.dd;
    const float sl = slope2 * (float)J.dd;
    St<4> s; st_init<4>(s, (mode == 0) ? sink2 + sl * (float)r32 : NEG, 0.f);
    f32x16 L;
#pragma unroll
    for (int r = 0; r < 16; ++r) L[r] = (mode == 0) ? 1.f : 0.f;
    int koff[4];
#pragma unroll
    for (int i = 0; i < 4; ++i) koff[i] = k_lds_off(r32, 2 * i + hi);
    const int troff = ((lane >> 4) & 1) * 32 + (lane & 3) * 8 + (4 * hi + ((lane & 15) >> 2)) * 64;
    const int nt = (ut + 1 < 5) ? ut + 1 : 5;
    step2<true>(s, L, qf, lds + KIMG + (qi + 4) * 4096, koff, lds + VIMG + (qi + 4) * 4096 + troff, sl, 0.f, true, mk_diag(), r32, hi);
    for (int k = 1; k < nt; ++k) { const int t = qi + 4 - k;
        step2<false>(s, L, qf, lds + KIMG + t * 4096, koff, lds + VIMG + t * 4096 + troff, sl, -32.f * sl * (float)k, true, (k == 4) ? mk_far(mode) : mk_none(), r32, hi); }
    const float lt = L[0], rl = __builtin_amdgcn_rcpf(lt);
    { const size_t q0r = (size_t)(J.U0 + 32 * qi) * J.dd * opitch, rstep = (size_t)J.dd * opitch;
      st_store_lds<4>(s, rl, stg, lane, [&](int row) { return out + q0r + (size_t)row * rstep; }); }
    if (mode == 1) lse[qoff * lpitch] = s.m + __builtin_amdgcn_logf(lt) - sl * (float)r32;
}

__device__ __forceinline__ void c_decode(const bf16* PJ, int vcu  , int k, BandJob& J, int& pat, int& b, int& h, int& r) { b = vcu >> 5; const int loc = k * 32 + (vcu & 31); h = loc / 48; const int rem = loc - h * 48; pat = rem >> 4; const int qg = rem & 15;
    const int dd = (pat == 0) ? 1 : (pat == 1 ? 4 : 16), tpr = 128 / dd, qt = qg * 8; r = qt / tpr; const int ut0 = qt % tpr;
    J.row0 = PJ + (size_t)(b * SEQ + r) * INW; J.dd = dd; J.U0 = ut0 * 32; J.T = 12; J.kcol = KC + h * 64; J.vcol = VC + h * 64; }
__device__ __forceinline__ void a_decode(const bf16* PJ, int au, BandJob& J, int& b, int& kvh) { b = au >> 7; kvh = (au >> 6) & 1; const int chunk = au & 63;
    J.row0 = PJ + (size_t)(b * SEQ) * INW; J.dd = 1; J.U0 = chunk * 64; J.T = 6; J.kcol = KA + kvh * 64; J.vcol = VA + kvh * 64; }
__device__ __forceinline__ void band_load_q(bf16x8 (&qf)[4], const BandJob& J, int qi, int qcol, int lane) { load_q<4>(qf, J.row0 + (size_t)(J.U0 + 32 * qi + (lane & 31)) * J.dd * INW + qcol + 8 * (lane >> 5)); }
__device__ __forceinline__ void mix_ca_phase(const bf16* PJ, const float* sinks, bf16* O, bf16* PART, float* LSE, LAS char* lds, int vcu, int wave, int lane) {
    const int tid = wave * 64 + lane;
    v4u kp[6], vp[6]; bf16x8 qf[4], qn[4];
    LAS char* stg = lds + 98304 + wave * 4096;
    {   BandJob J; int pat, b, h, r; c_decode(PJ, vcu, 0, J, pat, b, h, r); band_prefetch<6, (VC - KC) * 2>(kp, vp, J, tid); band_load_q(qf, J, wave, QC + h * 64, lane); band_wait<6, 0>(kp, vp);
        for (int k = 0; k < 24; ++k) {
            ATT2_BAR(); band_write<6>(kp, vp, lds, tid); ATT2_BAR();
            BandJob Jn = J; int patn = pat, bn = b, hn = h, rn = r; if (k + 1 < 24) { c_decode(PJ, vcu, k + 1, Jn, patn, bn, hn, rn); band_prefetch<6, (VC - KC) * 2>(kp, vp, Jn, tid); band_load_q(qn, Jn, wave, QC + hn * 64, lane); }
            const float slope2 = ex2(-0.5f * (float)(h + 1)) * LOG2E; const int op = (pat == 0) ? DM : 1024;
            bf16* out = (pat == 0) ? O + (size_t)(b * SEQ + r) * DM + 1024 + h * 64 : PART + ((size_t)(pat - 1) * M + (size_t)(b * SEQ + r)) * 1024 + h * 64;
            band_compute(J, wave, qf, slope2, 1, 0.f, out, op, LSE + ((size_t)pat * M + (size_t)(b * SEQ + r)) * 16 + h, 16, lds, stg, lane);
            band_wait<6, 5>(kp, vp);
            J = Jn; pat = patn; b = bn; h = hn; r = rn;
#pragma unroll
            for (int i = 0; i < 4; ++i) qf[i] = qn[i]; }
    }
    {   BandJob J; int b, kvh; a_decode(PJ, vcu * 4, J, b, kvh); band_prefetch<3, (VA - KA) * 2>(kp, vp, J, tid); band_load_q(qf, J, wave & 1, QA + (kvh * 4 + (wave >> 1)) * 64, lane);
        const float sink2 = sinks[kvh * 4 + (wave >> 1)] * LOG2E;
        band_wait<3, 0>(kp, vp);
        for (int k = 0; k < 4; ++k) {
            ATT2_BAR(); band_write<3>(kp, vp, lds, tid); ATT2_BAR();
            BandJob Jn = J; int bn = b, kvhn = kvh; if (k + 1 < 4) { a_decode(PJ, vcu * 4 + k + 1, Jn, bn, kvhn); band_prefetch<3, (VA - KA) * 2>(kp, vp, Jn, tid); band_load_q(qn, Jn, wave & 1, QA + (kvhn * 4 + (wave >> 1)) * 64, lane); }
            const int h = kvh * 4 + (wave >> 1); const float slope2 = ex2(-(float)(h + 1)) * LOG2E;
            band_compute(J, wave & 1, qf, slope2, 0, sink2, O + (size_t)(b * SEQ) * DM + h * 64, DM, nullptr, 0, lds, stg, lane);
            band_wait<3, 4>(kp, vp);
            J = Jn; b = bn; kvh = kvhn;
#pragma unroll
            for (int i = 0; i < 4; ++i) qf[i] = qn[i]; }
    }
    ATT2_BAR();
}

__device__ __forceinline__ void moba_prefetch(v4u (&kp)[4], v4u (&vp)[4], const bf16* blk0  , int tid) {
#pragma unroll
    for (int j = 0; j < 4; ++j) { const bf16* r = blk0 + (size_t)((tid >> 3) + 64 * j) * INW + (tid & 7) * 8; kp[j] = *(const GAS v4u*)r; vp[j] = *(const GAS v4u*)(r + (VB - KB)); }
}
__device__ __forceinline__ void moba_write(const v4u (&kp)[4], const v4u (&vp)[4], LAS char* buf, int tid) {
#pragma unroll
    for (int j = 0; j < 4; ++j) { const int row = (tid >> 3) + 64 * j, t = row >> 5, r = row & 31;
        *(LAS v4u*)(buf + t * 4096 + k_lds_off(r, tid & 7)) = kp[j];
        *(LAS v4u*)(buf + MV + t * 4096 + v_lds_off(r, tid & 7)) = vp[j]; }
}
__device__ __forceinline__ void moba_wg_item(const bf16* PJ, const float* KM, int b, int h, int blk, bf16* O, LAS char* lds, int wave, int lane) {
    const int tid = wave * 64 + lane, r32 = lane & 31, hi = lane >> 5, w = wave, brow = b * SEQ, q0 = blk * 256 + 32 * w;
    const bf16* kb0 = PJ + (size_t)brow * INW + KB + h * 64;
    v4u kp[4], vp[4];
    moba_prefetch(kp, vp, kb0 + (size_t)(blk * 256) * INW, tid);
    ATT2_BAR();
    if (tid < blk * 16) *(LAS f32x4*)(lds + KMS + tid * 16) = *(const GAS f32x4*)(KM + (size_t)(b * 16 + (tid >> 4)) * 512 + h * 64 + (tid & 15) * 4);
    bf16x8 qf[4]; load_q<4>(qf, PJ + (size_t)(brow + q0 + r32) * INW + QB + h * 64 + 8 * hi);
    const float slope2 = ex2(-(float)(h + 1)) * LOG2E;
    moba_write(kp, vp, lds, tid);
    ATT2_BAR();
    if (blk > 0) moba_prefetch(kp, vp, kb0 + (size_t)((blk - 1) * 256) * INW, tid);
    float g1 = -INFINITY, g2 = -INFINITY, g3 = -INFINITY; int i1 = -1, i2 = -1, i3 = -1;
    for (int n = 0; n < blk; ++n) { const LAS float* km = (const LAS float*)(lds + KMS) + n * 64 + 8 * hi; float g = 0.f;
#pragma unroll
        for (int i = 0; i < 4; ++i) { const f32x4 a = *(const LAS f32x4*)(km + 16 * i), c = *(const LAS f32x4*)(km + 16 * i + 4); const v4u wq = __builtin_bit_cast(v4u, qf[i]);
            g = fmaf(bflo(wq.x), a.x, g); g = fmaf(bfhi(wq.x), a.y, g); g = fmaf(bflo(wq.y), a.z, g); g = fmaf(bfhi(wq.y), a.w, g);
            g = fmaf(bflo(wq.z), c.x, g); g = fmaf(bfhi(wq.z), c.y, g); g = fmaf(bflo(wq.w), c.z, g); g = fmaf(bfhi(wq.w), c.w, g); }
        g = swapsum(g);
        if (g > g1) { g3 = g2; i3 = i2; g2 = g1; i2 = i1; g1 = g; i1 = n; } else if (g > g2) { g3 = g2; i3 = i2; g2 = g; i2 = n; } else if (g > g3) { g3 = g; i3 = n; } }
    unsigned selmask = 0u; if (i1 >= 0) selmask |= 1u << i1; if (i2 >= 0) selmask |= 1u << i2; if (i3 >= 0) selmask |= 1u << i3;
    St<4> s; st_init<4>(s, NEG, 0.f);
    f32x16 L;
#pragma unroll
    for (int r = 0; r < 16; ++r) L[r] = 0.f;
    int koff[4];
#pragma unroll
    for (int i = 0; i < 4; ++i) koff[i] = k_lds_off(r32, 2 * i + hi);
    const int troff = ((lane >> 4) & 1) * 32 + (lane & 3) * 8 + (4 * hi + ((lane & 15) >> 2)) * 64;
    { step2<true>(s, L, qf, lds + w * 4096, koff, lds + MV + w * 4096 + troff, slope2, 0.f, true, mk_diag(), r32, hi);
      for (int k = 1; k <= w; ++k) { const int t = w - k;
        step2<false>(s, L, qf, lds + t * 4096, koff, lds + MV + t * 4096 + troff, slope2, -32.f * slope2 * (float)k, true, mk_none(), r32, hi); } }
    for (int j = 1; j <= blk; ++j) { const int n = blk - j; LAS char* buf = lds + (j & 1) * MBUF;
        moba_write(kp, vp, buf, tid);
        ATT2_BAR();
        if (j < blk) moba_prefetch(kp, vp, kb0 + (size_t)((n - 1) * 256) * INW, tid);
        const bool sel = (selmask >> n) & 1u;
        if (__any(sel)) { const float tb0 = slope2 * (float)((n - blk) * 256 + 224 - 32 * w);
            for (int k = 0; k < 8; ++k) { const int t = 7 - k;
                step2<false>(s, L, qf, buf + t * 4096, koff, buf + MV + t * 4096 + troff, slope2, tb0 - 32.f * slope2 * (float)k, sel, mk_none(), r32, hi); } } }
    const float rl = __builtin_amdgcn_rcpf(L[0]);
    { bf16* ob = O + (size_t)(brow + q0) * DM + 512 + h * 64;
      st_store_lds<4>(s, rl, lds + ((blk + 1) & 1) * MBUF + wave * 4096, lane, [&](int row) { return ob + (size_t)row * DM; }); }
}
__device__ __forceinline__ void mix_b2_phase(const bf16* PJ, const float* KM, bf16* O, LAS char* lds, int vcu, int wave, int lane) {
    for (int pi = 0; pi < 2; ++pi) { const int b = vcu >> 5, tr = vcu & 31, h = pi * 4 + (tr >> 3), pr = tr & 7;
        moba_wg_item(PJ, KM, b, h, 15 - pr, O, lds, wave, lane);
        moba_wg_item(PJ, KM, b, h, pr, O, lds, wave, lane); }
    ATT2_BAR();
}
}

namespace att2 {
__device__ __forceinline__ void xattn_wg(const bf16* QX, const bf16* KVX  , bf16* OX, int pm, int pn, LAS char* lds, int wave, int lane) {
    const int tid = wave * 64 + lane, r32 = lane & 31, hi = lane >> 5, b = pm >> 4;
    const int troff = ((lane >> 4) & 1) * 32 + (lane & 3) * 8 + (4 * hi + ((lane & 15) >> 2)) * 64;
    int koff[8];
#pragma unroll
    for (int i = 0; i < 8; ++i) koff[i] = r32 * 256 + (((2 * i + hi) ^ (r32 & 15)) << 4);
    asm volatile("s_waitcnt vmcnt(0)" ::: "memory");
    for (int hh = 0; hh < 2; ++hh) { const int h = 2 * pn + hh;
        ATT2_BAR();
        { const bf16* src = KVX + (size_t)(b * MEML) * 1024 + h * 128 + (tid & 15) * 8;
#pragma unroll
          for (int j = 0; j < 8; ++j) { const int row = (tid >> 4) + 32 * j, ch = tid & 15; const v4u kk = *(const GAS v4u*)(src + (size_t)row * 1024), vv = *(const GAS v4u*)(src + (size_t)row * 1024 + 512);
              *(LAS v4u*)(lds + j * 8192 + (row & 31) * 256 + ((ch ^ (row & 15)) << 4)) = kk;
              *(LAS v4u*)(lds + 65536 + j * 8192 + (ch >> 2) * 2048 + (row & 31) * 64 + (ch & 3) * 16) = vv; } }
        bf16x8 qf[8]; load_q<8>(qf, QX + (size_t)(pm * 256 + wave * 32 + r32) * XW + h * 128 + 8 * hi);
        ATT2_BAR();
        St<8> s; st_init<8>(s, NEG, 0.f);
        f32x16 zero;
#pragma unroll
        for (int r = 0; r < 16; ++r) zero[r] = 0.f;
        for (int t = 0; t < 8; ++t) { bf16x8 kf[8];
#pragma unroll
            for (int i = 0; i < 8; ++i) kf[i] = *(const LAS bf16x8*)(lds + t * 8192 + koff[i]);
            step<8>(s, qf, kf, lds + 65536 + t * 8192 + troff, zero, 0.f, true, mk_none(), r32, hi); }
        const float rl = __builtin_amdgcn_rcpf(swapsum(s.l));
        ATT2_BAR();
        bf16* ob = OX + (size_t)(pm * 256 + wave * 32) * XW + h * 128;
        st_store_lds<8>(s, rl, lds + wave * 8192, lane, [&](int row) { return ob + (size_t)row * XW; });
    }
    ATT2_BAR();
}
}

#ifndef KM_ATOMIC
#define KM_ATOMIC 1
#endif
#ifndef RESID_ALIGN
#define RESID_ALIGN true
#endif
#ifndef FUSE_X
#define FUSE_X 1
#endif
#ifndef ATT_V2
#define ATT_V2 1
#endif
#ifndef MFMA_A
#define MFMA_A 1
#endif
#ifndef MFMA_B
#define MFMA_B 1
#endif
#ifndef MFMA_C
#define MFMA_C 1
#endif
#ifndef MFMA_X
#define MFMA_X 1
#endif
constexpr int PH_L0 = 2, PH_PER_LAYER = 9, PH_FINAL = PH_L0 + DEPTH * PH_PER_LAYER, PH_END = PH_FINAL + 1;
struct Args { Ptrs p; float* out; unsigned char* ws; int ph_lo, ph_hi, mixmask, pad; };
static_assert(sizeof(Args) == 22 * 8 + 16, "Args has no padding bytes");
__global__ void __launch_bounds__(NWAVES * 64, 2) trunk_fwd(Args args) {
    extern __shared__ __attribute__((aligned(16))) unsigned char lds_raw[];
    LAS unsigned char* lds = (LAS unsigned char*)lds_raw;
    volatile LAS unsigned* MISC = (volatile LAS unsigned*)(lds + MISC_OFF);
    const int tid = threadIdx.x, lane0 = tid & 63, wave = __builtin_amdgcn_readfirstlane(tid >> 6);
    const int G = gridDim.x; const int bx = blockIdx.x; const int vcu = (G % 8 == 0) ? (bx % 8) * (G / 8) + bx / 8 : bx;
    const int gw = vcu * NWAVES + wave, NGW = G * NWAVES, gtid0 = gw * 64 + lane0, nthr = NGW * 64;
    unsigned char* ws = args.ws; const Ptrs& P = args.p;
    gu32* ctl = (gu32*)(ws + WS_CTL);
    for (int u = tid; u < (LDS_BYTES - LDSCTL_OFF) / 4; u += NWAVES * 64) ((LAS unsigned*)(lds + LDSCTL_OFF))[u] = 0u;
    __syncthreads();
    XcdBarrier bar; bar.bar = (unsigned*)(ctl + CW_BAR); bar.x = xb_xcc_id(); bar.st = MISC + 8;
    if (tid == 0) MISC[10] = xcd_barrier_post_rank(bar.bar, bar.x);
    __syncthreads();
    const int xrank = __builtin_amdgcn_readfirstlane((int)MISC[10]);
    const int lo = args.ph_lo, hi = args.ph_hi;
#define IN(k) (lo <= (k) && (k) < hi)
#define SEAM(k) do { if (IN(k) && IN((k) + 1)) xcd_barrier2(bar, false); } while (0)
#define TSEAM(k) do { if (IN(k) && IN((k) + 1)) xcd_barrier2(bar, teams); } while (0)
    bf16* XN = (bf16*)(ws + WS_XN); bf16* BIG = (bf16*)(ws + WS_BIG); bf16* QX = (bf16*)(ws + WS_QX); bf16* OX = (bf16*)(ws + WS_OX);
    bf16* H16 = (bf16*)args.out;

    if (IN(0)) { p0_convert(P, ws, H16, (LAS char*)(lds + RING_OFF + wave * 16384), gw, NGW, lane0); }
    SEAM(0);
    bool teams = false;
    if (lo == 0 && hi == PH_END && G == 256) { if (tid == 0) { unsigned ok = 1u;
#pragma unroll
            for (unsigned j = 0; j < 16; ++j) { const unsigned c = xb_ld(&bar.bar[XB_XCNT(j)]); ok &= (j < 8u) ? (c == 32u) : (c == 0u); }
            MISC[11] = ok; }
        __syncthreads(); teams = __builtin_amdgcn_readfirstlane((int)MISC[11]) != 0; }
    const int vcu2 = teams ? (int)bar.x * 32 + xrank : vcu;
    for (int l = 0; l < DEPTH; ++l) {
        unsigned zl = 0u; asm volatile("" : "+s"(zl));
        int lane = (int)__builtin_amdgcn_mbcnt_hi(~0u, __builtin_amdgcn_mbcnt_lo(~0u, zl)), wave_l = wave, vcu_l = vcu2; asm volatile("" : "+v"(lane), "+s"(wave_l), "+s"(vcu_l));
        const int gtid = gw * 64 + lane; (void)gtid;
#define TEAMVARS int team = vcu_l >> 5, trank = vcu_l & 31; asm volatile("" : "+s"(team), "+s"(trank)); bf16* PJt = BIG + (size_t)team * (1u << 20); bf16* QXt = XN + (size_t)team * (6u << 20); bf16* OXt = XN + (2u << 20) + (size_t)team * (6u << 20); (void)PJt; (void)QXt; (void)OXt
        const int pb = PH_L0 + l * PH_PER_LAYER;
        unsigned char* wl = ws + WS_WL + (size_t)l * WL_STRIDE;
        float* KM = (float*)(ws + WS_KMEAN) + (size_t)l * (M / 256) * 512;
        unsigned long long* SS = (unsigned long long*)(ws + WS_SS) + (size_t)(3 * l) * M;
        bf16* PARTB = (bf16*)(ws + WS_PART);
#ifdef PROBE_DRY
        const bool dry = (args.mixmask & 8) != 0;
#else
        constexpr bool dry = false;
#endif
        bf16* RO = dry ? PARTB : H16; unsigned long long* SSD = (unsigned long long*)(ws + WS_SS) + (size_t)13 * M;
        if (IN(pb + 0)) { TEAMVARS; pg8::Gemm g{H16, (const bf16*)(wl + WL_IN), M, INW, DM}; pg8::TeamOrder S{INW / 256, team, trank};
            pg8::EpiBf16S E{PJt, INW, C2, (1u << 0) | (1u << 1) | (1u << 3) | (1u << 4) | (1u << 9) | (1u << 10) | (1u << 11) | (1u << 12), 0xff, SS, KM_ATOMIC ? KM : nullptr, (pg8::lds_f32*)(lds + RING_BYTES + 10240), (l * 4 + 1) << 9};
            pg8::gemm_phase<pg8::EpiBf16S, pg8::TeamOrder, true, true>(lds + RING_OFF, g, S, E, wave_l);
            if (trank >= 28) {
                const int ku = team * 4 + (trank - 28);
                pg8::Gemm gk{(const bf16*)(ws + WS_MEMN) + (size_t)l * MROWS * DM, (const bf16*)(ws + WS_WKV) + (size_t)l * 1024 * DM, MROWS, 1024, DM}; pg8::OneUnit SK{ku >> 2, ku & 3};
                pg8::EpiBf16S EK{(bf16*)(ws + WS_KVX) + (size_t)l * MROWS * 1024, 1024, 1.f, 0u, 0xff, nullptr, nullptr, (pg8::lds_f32*)(lds + RING_BYTES + 10240), 0};
                pg8::gemm_phase<pg8::EpiBf16S, pg8::OneUnit, true, true>(lds + RING_OFF, gk, SK, EK, wave_l); } }
        TSEAM(pb + 0);
#if !KM_ATOMIC
        if (IN(pb + 0)) { kmean_phase(BIG, KM, gw, NGW, lane); xcd_barrier2(bar, false); }
#endif
        if (IN(pb + 1)) { TEAMVARS;
#if ATT_V2
            if (args.mixmask & 1) att2::mix_b2_phase(PJt, KM, XN, (LAS char*)lds, vcu_l, wave_l, lane);
            if (args.mixmask & 6) att2::mix_ca_phase(PJt, P.sinks + l * 8, XN, PARTB, (float*)(ws + WS_LSE), (LAS char*)lds, vcu_l, wave_l, lane);
#else
            LAS char* vl = (LAS char*)(lds + RING_OFF + wave_l * 16384);
            if (args.mixmask & 1) mix_b_phase(BIG, KM, XN, vl, vcu_l, wave_l, lane);
            if (args.mixmask & 2) mix_c_phase(BIG, XN, PARTB, (float*)(ws + WS_LSE), vl, vcu_l, wave_l, lane);
            if (args.mixmask & 4) mix_a_phase(BIG, P.sinks + l * 8, XN, vl, vcu_l, wave_l, lane);
#endif
        }
        TSEAM(pb + 1);
        if (IN(pb + 2)) { TEAMVARS; ynorm_phase<MFMA_C != 0>(XN, dry ? BIG : XN, PARTB, (const float*)(ws + WS_LSE), P.gain_a + l * 512, P.gain_b + l * 512, P.gain_c + l * 1024, team * SEQ + trank * NWAVES + wave_l, (team + 1) * SEQ, 32 * NWAVES, lane); }
        TSEAM(pb + 2);
        if (IN(pb + 3)) { TEAMVARS; pg8::Gemm g{XN, (const bf16*)(wl + WL_OUT), M, DM, DM}; pg8::TeamOrder S{DM / 256, team, trank};
            pg8::EpiResid E{H16, RO, DM, dry ? SSD : SS + M, (LAS unsigned long long*)(lds + RING_BYTES + 8192)};
            pg8::gemm_phase<pg8::EpiResid, pg8::TeamOrder, RESID_ALIGN, true>(lds + RING_OFF, g, S, E, wave_l); }
        TSEAM(pb + 3);
        if (IN(pb + 4)) { TEAMVARS; pg8::Gemm g{H16, (const bf16*)(wl + WL_Q), M, XW, DM}; pg8::TeamOrder S{XW / 256, team, trank};
            pg8::EpiBf16S E{QXt, XW, CX2, 3u, 0xff, SS + M, nullptr, (pg8::lds_f32*)(lds + RING_BYTES + 10240), (l * 4 + 2) << 9};
            pg8::gemm_phase<pg8::EpiBf16S, pg8::TeamOrder, true, true>(lds + RING_OFF, g, S, E, wave_l);
#if FUSE_X
            pg8::Unit u; for (int i = 0; S.next(i, u); ++i) att2::xattn_wg(QXt, (const bf16*)(ws + WS_KVX) + (size_t)l * MROWS * 1024, OXt, u.pm, u.pn, (LAS char*)lds, wave_l, lane);
#endif
        }
        TSEAM(pb + 4);
#if !FUSE_X
#if MFMA_X
        if (IN(pb + 5)) mix_x_phase(QX, (const bf16*)(ws + WS_KVX) + (size_t)l * MROWS * 1024, OX, (LAS char*)(lds + RING_OFF + wave_l * 16384), vcu_l, wave_l, lane);
#else
        if (IN(pb + 5)) naive_attn_x(QX, (const bf16*)(ws + WS_KVX) + (size_t)l * MROWS * 1024, OX, gtid, nthr);
#endif
        TSEAM(pb + 5);
#endif
        if (IN(pb + 6)) { TEAMVARS; pg8::Gemm g{OXt, (const bf16*)(wl + WL_O), M, DM, XW}; pg8::TeamOrder S{DM / 256, team, trank};
            pg8::EpiResid E{H16, RO, DM, dry ? SSD : SS + 2 * M, (LAS unsigned long long*)(lds + RING_BYTES + 8192)};
            pg8::gemm_phase<pg8::EpiResid, pg8::TeamOrder, RESID_ALIGN, true>(lds + RING_OFF, g, S, E, wave_l); }
        TSEAM(pb + 6);
        if (IN(pb + 7)) { TEAMVARS; pg8::Gemm g{H16, (const bf16*)(wl + WL_GU), M, NGU, DM}; pg8::TeamOrder S{NGU / 256, team, trank};
            pg8::EpiSwiGLU E{BIG, DFF, SS + 2 * M, (args.mixmask & 32) ? 2 : ((args.mixmask & 16) ? 1 : 0), (pg8::lds_f32*)(lds + RING_BYTES + 10240), (l * 4 + 3) << 9};
            pg8::gemm_phase<pg8::EpiSwiGLU, pg8::TeamOrder, true, true>(lds + RING_OFF, g, S, E, wave_l); }
        TSEAM(pb + 7);
        if (IN(pb + 8)) { TEAMVARS; pg8::Gemm g{BIG, (const bf16*)(wl + WL_DN), M, DM, DFF}; pg8::TeamOrder S{DM / 256, team, trank};
            pg8::EpiResid E{H16, dry ? PARTB : ((l == DEPTH - 1) ? XN : H16), DM, dry ? SSD : SS + 3 * M, (LAS unsigned long long*)(lds + RING_BYTES + 8192)};
            pg8::gemm_phase<pg8::EpiResid, pg8::TeamOrder, RESID_ALIGN, true>(lds + RING_OFF, g, S, E, wave_l); }
        if (l == DEPTH - 1) SEAM(pb + 8); else TSEAM(pb + 8);
    }
    if (IN(PH_FINAL)) {
        unsigned zl = 0u; asm volatile("" : "+s"(zl));
        int lane = (int)__builtin_amdgcn_mbcnt_hi(~0u, __builtin_amdgcn_mbcnt_lo(~0u, zl)), gwf = gw; asm volatile("" : "+v"(lane), "+s"(gwf));
        f32x4 g[4][2];
#pragma unroll
        for (int j = 0; j < 4; ++j) { g[j][0] = *(const GAS f32x4*)(P.norm_final + 512 * j + 8 * lane); g[j][1] = *(const GAS f32x4*)(P.norm_final + 512 * j + 8 * lane + 4); }
        int team = vcu2 >> 5, trank = vcu2 & 31; asm volatile("" : "+s"(team), "+s"(trank)); (void)gwf;
        for (int m0 = team * SEQ + trank * NWAVES + wave; m0 < (team + 1) * SEQ; m0 += 2 * 32 * NWAVES) { v4u w4[2][4];
#pragma unroll
            for (int q = 0; q < 2; ++q) { const GAS v4u* row = (const GAS v4u*)(XN + (size_t)(m0 + q * 32 * NWAVES) * DM) + lane;
#pragma unroll
                for (int j = 0; j < 4; ++j) w4[q][j] = row[64 * j]; }
#pragma unroll
            for (int q = 0; q < 2; ++q) { const int m = m0 + q * 32 * NWAVES; float v[4][8]; float s = 0.f;
#pragma unroll
                for (int j = 0; j < 4; ++j) { const v4u w = w4[q][j]; v[j][0] = bflo(w.x); v[j][1] = bfhi(w.x); v[j][2] = bflo(w.y); v[j][3] = bfhi(w.y); v[j][4] = bflo(w.z); v[j][5] = bfhi(w.z); v[j][6] = bflo(w.w); v[j][7] = bfhi(w.w);
#pragma unroll
                    for (int e2 = 0; e2 < 8; ++e2) s += v[j][e2] * v[j][e2]; }
                const float rstd = 1.f / sqrtf(wave_sum(s) * (1.f / DM) + EPS);
                GAS f32x4* o = (GAS f32x4*)(args.out + (size_t)m * DM + 8 * lane);
#pragma unroll
                for (int j = 0; j < 4; ++j) { o[128 * j] = (f32x4){v[j][0] * rstd * g[j][0].x, v[j][1] * rstd * g[j][0].y, v[j][2] * rstd * g[j][0].z, v[j][3] * rstd * g[j][0].w};
                    o[128 * j + 1] = (f32x4){v[j][4] * rstd * g[j][1].x, v[j][5] * rstd * g[j][1].y, v[j][6] * rstd * g[j][1].z, v[j][7] * rstd * g[j][1].w}; } } }
    }
#undef IN
#undef SEAM
#undef TSEAM
}

#ifndef MK_MODE
#define MK_MODE 1
#endif
extern "C" void kernel_launch(void* const* d_in, const int* in_sizes, int n_in, void* d_out, int out_size, void* d_ws, size_t ws_size, hipStream_t stream) {
    static int grid = 0;
    if (grid == 0) {
        if (n_in != 20 || in_sizes[0] != M * DM || out_size != M * DM || ws_size < WS_END) { fprintf(stderr, "kernel_launch: unexpected shapes / workspace (%zu < %zu)\n", ws_size, (size_t)WS_END); grid = -1; return; }
        int dev = 0, cus = 0, per_cu = 0;
        if (hipGetDevice(&dev) != hipSuccess || hipDeviceGetAttribute(&cus, hipDeviceAttributeMultiprocessorCount, dev) != hipSuccess) { grid = -1; return; }
        if (hipFuncSetAttribute((const void*)trunk_fwd, hipFuncAttributeMaxDynamicSharedMemorySize, LDS_BYTES) != hipSuccess) { grid = -1; return; }
        if (hipOccupancyMaxActiveBlocksPerMultiprocessor(&per_cu, (const void*)trunk_fwd, NWAVES * 64, LDS_BYTES) != hipSuccess || per_cu < 1) { fprintf(stderr, "kernel_launch: occupancy query reports %d\n", per_cu); }
        (void)hipGetLastError();
        grid = cus;
        if (grid != 256) { fprintf(stderr, "kernel_launch: the static work deal of this kernel is built for 256 CUs (MI355X); found %d: nothing launched\n", cus); grid = -1; return; }
    }
    if (grid < 0) return;
    if (hipMemsetAsync((char*)d_ws + WS_CTL, 0, CTL_ZERO_BYTES, stream) != hipSuccess) return;
    if (hipMemsetAsync((char*)d_ws + WS_SS, 0, SS_BYTES, stream) != hipSuccess) return;
    Args a{};
    const float** pp = (const float**)&a.p;
    for (int i = 0; i < 20; ++i) pp[i] = (const float*)d_in[i];
    a.out = (float*)d_out; a.ws = (unsigned char*)d_ws; a.mixmask = 7;
#if MK_MODE == 1
    a.ph_lo = 0; a.ph_hi = PH_END;
    hipLaunchKernelGGL(trunk_fwd, dim3(grid), dim3(NWAVES * 64), LDS_BYTES, stream, a);
#else
    for (int k = 0; k < PH_END; ++k) {
        a.ph_lo = k; a.ph_hi = k + 1; a.mixmask = 7;
#ifdef PROBE_DRY
        if (k >= PH_L0 && k < PH_FINAL && (k - PH_L0) % PH_PER_LAYER == PROBE_DRY) { a.mixmask = 15; hipLaunchKernelGGL(trunk_fwd, dim3(grid), dim3(NWAVES * 64), LDS_BYTES, stream, a); a.mixmask = 7; }
#endif
        hipLaunchKernelGGL(trunk_fwd, dim3(grid), dim3(NWAVES * 64), LDS_BYTES, stream, a);
#ifdef PROBE_PH
        if ((PROBE_PH >= 0 && k >= PH_L0 && k < PH_FINAL && (k - PH_L0) % PH_PER_LAYER == PROBE_PH) || (PROBE_PH == -1 && k == 0) || (PROBE_PH == -2 && k == 1)) {
            a.mixmask = PROBE_MIX; hipLaunchKernelGGL(trunk_fwd, dim3(grid), dim3(NWAVES * 64), LDS_BYTES, stream, a); }
#endif
    }
#endif
}
```

```cpp
#include <hip/hip_runtime.h>
#include <cstdio>
#include <cstdint>
template <int CTRL> __device__ __forceinline__ float lane_dpp(float v) { return __builtin_bit_cast(float, __builtin_amdgcn_update_dpp(0, __builtin_bit_cast(int, v), CTRL, 0xf, 0xf, true)); }
__device__ __forceinline__ float sum_row16(float v) {
    v += lane_dpp<0xB1>(v); v += lane_dpp<0x4E>(v); v += lane_dpp<0x141>(v); v += lane_dpp<0x140>(v); return v; }
__device__ __forceinline__ float sum_x16(float v) { return v + __builtin_bit_cast(float, __builtin_amdgcn_ds_swizzle(__builtin_bit_cast(int, v), 0x401f)); }
__device__ __forceinline__ void swap32(float v, float& a, float& b) { float x = v, y = v; asm volatile("s_nop 1\n\tv_permlane32_swap_b32 %0, %1" : "+v"(x), "+v"(y)); a = x; b = y; }
__device__ __forceinline__ float sum_x32(float v) { float a, b; swap32(v, a, b); return a + b; }
namespace pg8 {
#define PG8_LAS __attribute__((address_space(3)))
typedef unsigned short bf16_t;
typedef short bf16x8 __attribute__((ext_vector_type(8)));
typedef float f32x4 __attribute__((ext_vector_type(4)));
typedef unsigned u32x4 __attribute__((ext_vector_type(4)));
constexpr int BM = 256, BK = 64, HALF = 128, HTB = HALF * BK * 2  , STAGE_BYTES = 8 * HTB, NXCD = 8, WGM = 8;

__host__ __device__ __forceinline__ int lds_byte(int r, int c) { const int st = (r >> 4) * 2 + (c >> 5), rr = r & 15, cc = c & 31, ob = rr * 64 + cc * 2; return st * 1024 + (ob ^ (((ob >> 9) & 1) << 5)); }
__host__ __device__ __forceinline__ void stage_rc(int b, int& R, int& C) { const int st = b / 1024, sb = b % 1024, swz = sb ^ (((sb >> 9) & 1) << 5); R = (st >> 1) * 16 + swz / 64; C = (st & 1) * 32 + (swz % 64) / 2; }
__host__ __device__ __forceinline__ int perm32(int rho) { const int n = rho >> 4, i = rho & 15; return 8 * (i >> 2) + 4 * n + (i & 3); }

struct Unit { int pm, pn; };
struct Gemm { const bf16_t* A; const bf16_t* Bt; int M, N, K; };

struct StaticOrder {
    int nM, nN, nwg, G, c;
    __host__ __device__ void init(int M, int N, int G_, int c_) { nM = M / BM; nN = N / BM; nwg = nM * nN; G = G_; c = c_; }
    __host__ __device__ bool next(int i, Unit& u) const {
        const long L = (long)i * G + c; if (L >= nwg) return false;
        int wgid = (int)L; { const int q = nwg / NXCD, r = nwg % NXCD, xcd = wgid % NXCD, off = wgid / NXCD; wgid = (xcd < r ? xcd * (q + 1) : r * (q + 1) + (xcd - r) * q) + off; }
        const int nig = WGM * nN, gid = wgid / nig, fm = gid * WGM, gsz = (nM - fm) < WGM ? (nM - fm) : WGM;
        u.pm = fm + ((wgid % nig) % gsz); u.pn = (wgid % nig) / gsz; return true;
    }
    __device__ __forceinline__ void a_ready(const Unit&) const {}
    __device__ __forceinline__ void done(const Unit&) const {}
};


typedef unsigned wt_v4u __attribute__((ext_vector_type(4)));
__device__ __forceinline__ __amdgpu_buffer_rsrc_t wt_rsrc(const void* base) { return __builtin_amdgcn_make_buffer_rsrc((void*)base, (short)0, 0x7ffffff0, 0x00020000); }
__device__ __forceinline__ void wt_store16(__amdgpu_buffer_rsrc_t rs, size_t byteoff, u32x4 v) { __builtin_amdgcn_raw_buffer_store_b128(__builtin_bit_cast(wt_v4u, v), rs, (int)(unsigned)byteoff, 0, 16); }
typedef float cv_f32x2 __attribute__((ext_vector_type(2)));
typedef __bf16 cv_bf16x2 __attribute__((ext_vector_type(2)));
__device__ __forceinline__ unsigned cvt_pk_bf16(float lo, float hi) { cv_f32x2 v = {lo, hi}; return __builtin_bit_cast(unsigned, __builtin_convertvector(v, cv_bf16x2)); }

#ifndef SS_ATOMIC
#define SS_ATOMIC 1
#endif
__device__ __forceinline__ float rstd_of(unsigned long long q) { const float s = (float)(unsigned)(q >> 32) + (float)(unsigned)q * (1.f / 4294967296.f); return __builtin_amdgcn_rsqf(s * (1.f / 2048.f) + 1e-5f); }
typedef __attribute__((address_space(3))) float lds_f32;
typedef __attribute__((address_space(3))) int lds_i32;
__device__ __forceinline__ void rstd_rows(float (&rs)[2][4], const unsigned long long* ss, int row0, int tag, lds_f32* stash  , int wid, int fr, int fq) {
    lds_f32* mine = stash + wid * 128; lds_i32* tagw = (lds_i32*)(stash + 8 * 128) + wid;
    const int have = __builtin_amdgcn_readfirstlane(*tagw);
    if (have == tag) {
#pragma unroll
        for (int ai = 0; ai < 2; ++ai)
#pragma unroll
            for (int m = 0; m < 4; ++m) rs[ai][m] = mine[ai * 64 + m * 16 + fr];
    } else {
        unsigned long long sv[2][4];
#pragma unroll
        for (int ai = 0; ai < 2; ++ai)
#pragma unroll
            for (int m = 0; m < 4; ++m) sv[ai][m] = ss[row0 + ai * HALF + m * 16];
#pragma unroll
        for (int ai = 0; ai < 2; ++ai)
#pragma unroll
            for (int m = 0; m < 4; ++m) { rs[ai][m] = rstd_of(sv[ai][m]); if (fq == 0) mine[ai * 64 + m * 16 + fr] = rs[ai][m]; }
        *tagw = tag;
    }
}
struct EpiBf16S {
    static constexpr bool PERM = true, AFTER_DRAIN = false;
    bf16_t* O; int ldc; float scale; unsigned smask; int pn_and; const unsigned long long* ss; float* km; lds_f32* stash; int tag0;
    __device__ __forceinline__ void operator()(const f32x4 (&acc)[2][2][4][2], const Unit& u, int wr, int wc, int fr, int fq) const {
        const int row0 = u.pm * BM + wr * 64 + fr; const int pn = u.pn & pn_and; const int col0 = pn * BM + wc * 32 + 8 * fq;
        const float sc = ((smask >> pn) & 1u) ? scale : 1.f;
        const bool dokm = (km != nullptr) && (pn == 5 || pn == 6);
        f32x4 cs[2][2];
#pragma unroll
        for (int bj = 0; bj < 2; ++bj) { cs[bj][0] = (f32x4){0.f, 0.f, 0.f, 0.f}; cs[bj][1] = (f32x4){0.f, 0.f, 0.f, 0.f}; }
        float rsv[2][4];
        if (ss) rstd_rows(rsv, ss, row0, tag0 + u.pm + 1, stash, wr * 4 + wc, fr, fq);
#pragma unroll
        for (int ai = 0; ai < 2; ++ai)
#pragma unroll
            for (int m = 0; m < 4; ++m) { const int row = row0 + ai * HALF + m * 16; const size_t ro = ((size_t)row * ldc + col0) * 2;
                float rs = sc; if (ss) rs *= rsv[ai][m];
#pragma unroll
                for (int bj = 0; bj < 2; ++bj) { f32x4 v0 = acc[ai][bj][m][0] * rs, v1 = acc[ai][bj][m][1] * rs;
                    cs[bj][0] += v0; cs[bj][1] += v1;
                    u32x4 w; w.x = cvt_pk_bf16(v0[0], v0[1]); w.y = cvt_pk_bf16(v0[2], v0[3]); w.z = cvt_pk_bf16(v1[0], v1[1]); w.w = cvt_pk_bf16(v1[2], v1[3]);
                    *(u32x4*)(O + (ro >> 1) + bj * HALF) = w; } }
        if (dokm) { float mine = 0.f;
#pragma unroll
            for (int bj = 0; bj < 2; ++bj)
#pragma unroll
                for (int n = 0; n < 2; ++n)
#pragma unroll
                    for (int i = 0; i < 4; ++i) { const float v = sum_row16(cs[bj][n][i]); mine = (fr == bj * 8 + n * 4 + i) ? v : mine; }
            unsafeAtomicAdd(km + (size_t)u.pm * 512 + (col0 - 1280) + (fr >> 3) * HALF + (fr & 7), mine); }
    }
};
struct EpiResid {
    static constexpr bool PERM = true, AFTER_DRAIN = false;
    const bf16_t* in; bf16_t* out; int ldc; unsigned long long* ss_out; __attribute__((address_space(3))) unsigned long long* lss;
    __device__ __forceinline__ void operator()(const f32x4 (&acc)[2][2][4][2], const Unit& u, int wr, int wc, int fr, int fq) const {
        const int row0 = u.pm * BM + wr * 64 + fr, col0 = u.pn * BM + wc * 32 + 8 * fq;
        u32x4 rin[2][4][2];
#pragma unroll
        for (int ai = 0; ai < 2; ++ai)
#pragma unroll
            for (int m = 0; m < 4; ++m)
#pragma unroll
                for (int bj = 0; bj < 2; ++bj) rin[ai][m][bj] = *(const u32x4*)(in + (size_t)(row0 + ai * HALF + m * 16) * ldc + col0 + bj * HALF);
#pragma unroll
        for (int ai = 0; ai < 2; ++ai)
#pragma unroll
            for (int m = 0; m < 4; ++m) { const int row = row0 + ai * HALF + m * 16; const size_t off = (size_t)row * ldc + col0;
                typedef float f32x2 __attribute__((ext_vector_type(2)));
                f32x2 sq2 = {0.f, 0.f};
#pragma unroll
                for (int bj = 0; bj < 2; ++bj) { const u32x4 w0 = rin[ai][m][bj];
                    const f32x4 a0 = acc[ai][bj][m][0], a1 = acc[ai][bj][m][1];
                    f32x2 p0 = (f32x2){a0[0], a0[1]} + (f32x2){__builtin_bit_cast(float, w0.x << 16), __builtin_bit_cast(float, w0.x & 0xffff0000u)};
                    f32x2 p1 = (f32x2){a0[2], a0[3]} + (f32x2){__builtin_bit_cast(float, w0.y << 16), __builtin_bit_cast(float, w0.y & 0xffff0000u)};
                    f32x2 p2 = (f32x2){a1[0], a1[1]} + (f32x2){__builtin_bit_cast(float, w0.z << 16), __builtin_bit_cast(float, w0.z & 0xffff0000u)};
                    f32x2 p3 = (f32x2){a1[2], a1[3]} + (f32x2){__builtin_bit_cast(float, w0.w << 16), __builtin_bit_cast(float, w0.w & 0xffff0000u)};
                    sq2 = __builtin_elementwise_fma(p0, p0, sq2); sq2 = __builtin_elementwise_fma(p1, p1, sq2); sq2 = __builtin_elementwise_fma(p2, p2, sq2); sq2 = __builtin_elementwise_fma(p3, p3, sq2);
                    u32x4 w; w.x = cvt_pk_bf16(p0.x, p0.y); w.y = cvt_pk_bf16(p1.x, p1.y); w.z = cvt_pk_bf16(p2.x, p2.y); w.w = cvt_pk_bf16(p3.x, p3.y);
                    *(u32x4*)(out + off + bj * HALF) = w; }
                float sq = sq2.x + sq2.y;
                sq = sum_x32(sum_x16(sq));
                if (SS_ATOMIC && fq == 0) { const unsigned hi_ = (unsigned)sq, lo_ = (unsigned)((sq - (float)hi_) * 4294967296.f);
                    __hip_atomic_fetch_add(lss + (wr * 128 + ai * 64 + m * 16 + fr), ((unsigned long long)hi_ << 32) | lo_, __ATOMIC_RELAXED, __HIP_MEMORY_SCOPE_WORKGROUP); } }
        if (SS_ATOMIC) {
            asm volatile("s_waitcnt lgkmcnt(0)\n\ts_barrier" ::: "memory");
            const int ln = fq * 16 + fr;
            if (ln < 32) { const int d = wr * 128 + wc * 32 + ln; const unsigned long long v = lss[d]; lss[d] = 0ull;
                atomicAdd(ss_out + (u.pm * BM + ((d >> 6) & 1) * HALF + wr * 64 + ((d >> 4) & 3) * 16 + (d & 15)), v); } }
    }
};
struct EpiSwiGLU {
    static constexpr bool PERM = true, AFTER_DRAIN = false;
    bf16_t* O; int ldc; const unsigned long long* ss; int nostore; lds_f32* stash; int tag0;
    __device__ __forceinline__ void operator()(const f32x4 (&acc)[2][2][4][2], const Unit& u, int wr, int wc, int fr, int fq) const {
        if (nostore == 2) return;
        const int row0 = u.pm * BM + wr * 64 + fr, col0 = u.pn * HALF + wc * 32 + 8 * fq;
        float rsv[2][4];
        rstd_rows(rsv, ss, row0, tag0 + u.pm + 1, stash, wr * 4 + wc, fr, fq);
#pragma unroll
        for (int ai = 0; ai < 2; ++ai)
#pragma unroll
            for (int m = 0; m < 4; ++m) { const int row = row0 + ai * HALF + m * 16; const size_t ro = ((size_t)row * ldc + col0) * 2;
                typedef float f32x2 __attribute__((ext_vector_type(2)));
                const float rs = rsv[ai][m], c1 = -1.4426950408889634f * rs, rs2 = rs * rs;
                f32x2 G[4], U[4], T[4];
#pragma unroll
                for (int i = 0; i < 4; ++i) { G[i] = (f32x2){acc[ai][0][m][i >> 1][2 * (i & 1)], acc[ai][0][m][i >> 1][2 * (i & 1) + 1]}; U[i] = (f32x2){acc[ai][1][m][i >> 1][2 * (i & 1)], acc[ai][1][m][i >> 1][2 * (i & 1) + 1]}; }
#pragma unroll
                for (int i = 0; i < 4; ++i) T[i] = G[i] * c1;
#pragma unroll
                for (int i = 0; i < 4; ++i) T[i] = (f32x2){__builtin_amdgcn_exp2f(T[i].x), __builtin_amdgcn_exp2f(T[i].y)};
#pragma unroll
                for (int i = 0; i < 4; ++i) T[i] = T[i] + 1.f;
#pragma unroll
                for (int i = 0; i < 4; ++i) T[i] = (f32x2){__builtin_amdgcn_rcpf(T[i].x), __builtin_amdgcn_rcpf(T[i].y)};
#pragma unroll
                for (int i = 0; i < 4; ++i) T[i] = ((G[i] * U[i]) * T[i]) * rs2;
                u32x4 w; w.x = cvt_pk_bf16(T[0].x, T[0].y); w.y = cvt_pk_bf16(T[1].x, T[1].y); w.z = cvt_pk_bf16(T[2].x, T[2].y); w.w = cvt_pk_bf16(T[3].x, T[3].y);
                if (!nostore) *(u32x4*)(O + (ro >> 1)) = w; }
    }
};
struct TeamOrder {
    int nN, t, r;
    __device__ __forceinline__ bool next(int i, Unit& u) const { const int li = i * 32 + r; if (li >= 16 * nN) return false; const int gid = li / (8 * nN), idx = li % (8 * nN);
        u.pm = 16 * t + 8 * gid + (idx & 7); u.pn = idx >> 3; return true; }
    __device__ __forceinline__ void a_ready(const Unit&) const {}
    __device__ __forceinline__ void done(const Unit&) const {}
};
struct OneUnit {
    int pm, pn;
    __device__ __forceinline__ bool next(int i, Unit& u) const { if (i != 0) return false; u.pm = pm; u.pn = pn; return true; }
    __device__ __forceinline__ void a_ready(const Unit&) const {}
    __device__ __forceinline__ void done(const Unit&) const {}
};
struct KvOrder {
    int G, c;
    __device__ __forceinline__ bool next(int i, Unit& u) const { const int L = i * G + c; if (L >= 128) return false; u.pm = L >> 2; u.pn = ((L >> 5) << 2) + (L & 3); return true; }
    __device__ __forceinline__ void a_ready(const Unit&) const {}
    __device__ __forceinline__ void done(const Unit&) const {}
};
template <class Epi, class Sched, bool ALIGN_EPI = false, bool SP2 = false>
__device__ __forceinline__ void gemm_phase(PG8_LAS unsigned char* lds, const Gemm g, const Sched& S, const Epi& E, const int wave_id  ) {
    unsigned z_ = 0u; asm volatile("" : "+s"(z_));
    int tid_ = wave_id * 64 + (int)__builtin_amdgcn_mbcnt_hi(~0u, __builtin_amdgcn_mbcnt_lo(~0u, z_));
    const int tid = tid_, wid = __builtin_amdgcn_readfirstlane(tid >> 6), lane = tid & 63, wr = wid >> 2, wc = wid & 3, fr = lane & 15, fq = lane >> 4;
    const int K = g.K, nt = K / BK;
    unsigned voffA[2], voffB[2];
#pragma unroll
    for (int i = 0; i < 2; ++i) { int R, C; stage_rc(tid * 16 + i * 8192, R, C); const int Rb = Epi::PERM ? ((R & ~31) + perm32(R & 31)) : R;
        voffA[i] = (unsigned)(R * K + C) * 2u; voffB[i] = (unsigned)(Rb * K + C) * 2u; }
    const size_t kstep = (size_t)(BK * 2);
    const size_t hstep = (size_t)HALF * K * 2;
    const size_t tstep = 2 * hstep;
    const unsigned ldsw = (unsigned)wid * 1024u;
    const int aoff = lds_byte(wr * 64 + fr, fq * 8), boff = lds_byte(wc * 32 + fr, fq * 8);
#define PG8_SA(b, h) (((b) * 2 + (h)) * HTB)
#define PG8_SB(b, h) ((4 + (b) * 2 + (h)) * HTB)
#define PG8_STAGE(bufoff, gbase, voff) do { _Pragma("unroll") for (int _i = 0; _i < 2; ++_i) \
        __builtin_amdgcn_global_load_lds((const unsigned*)((const char*)(gbase) + (voff)[_i]), (PG8_LAS unsigned*)(lds + (bufoff) + ldsw + _i * 8192), 16, 0, 0); } while (0)
#define PG8_LDA(dst, b, h) do { _Pragma("unroll") for (int m = 0; m < 4; ++m) _Pragma("unroll") for (int k = 0; k < 2; ++k) dst[m][k] = *(const PG8_LAS bf16x8*)(lds + PG8_SA(b, h) + aoff + m * 2048 + k * 1024); } while (0)
#define PG8_LDB(dst, b, h) do { _Pragma("unroll") for (int n = 0; n < 2; ++n) _Pragma("unroll") for (int k = 0; k < 2; ++k) dst[n][k] = *(const PG8_LAS bf16x8*)(lds + PG8_SB(b, h) + boff + n * 2048 + k * 1024); } while (0)
#define PG8_MMA(ai, bj, At, Bt) do { __builtin_amdgcn_s_setprio(1); _Pragma("unroll") for (int m = 0; m < 4; ++m) _Pragma("unroll") for (int n = 0; n < 2; ++n) _Pragma("unroll") for (int k = 0; k < 2; ++k) \
        acc[ai][bj][m][n] = __builtin_amdgcn_mfma_f32_16x16x32_bf16(Bt[n][k], At[m][k], acc[ai][bj][m][n], 0, 0, 0); __builtin_amdgcn_s_setprio(0); } while (0)
#define PG8_WAIT_V(n) asm volatile("s_waitcnt vmcnt(" #n ")" ::: "memory")
#define PG8_WAIT_L(n) asm volatile("s_waitcnt lgkmcnt(" #n ")" ::: "memory")
#define PG8_BAR __builtin_amdgcn_s_barrier()
#define PG8_SCHED __builtin_amdgcn_sched_barrier(0)
    Unit cur, nxt; int ui = 0;
    if (!S.next(0, cur)) return;
    f32x4 acc[2][2][4][2];
#pragma unroll
    for (int a = 0; a < 2; ++a)
#pragma unroll
        for (int b = 0; b < 2; ++b)
#pragma unroll
            for (int m = 0; m < 4; ++m)
#pragma unroll
                for (int n = 0; n < 2; ++n) acc[a][b][m][n] = (f32x4){0.f, 0.f, 0.f, 0.f};
    bf16x8 At[4][2], B0[2][2], B1[2][2];
    const char* cA = (const char*)g.A + (size_t)cur.pm * tstep; const char* cB = (const char*)g.Bt + (size_t)cur.pn * tstep;
    S.a_ready(cur);
    if constexpr (SP2) {
        PG8_STAGE(PG8_SB(0, 0), cB, voffB); PG8_STAGE(PG8_SB(0, 1), cB + hstep, voffB); PG8_STAGE(PG8_SA(0, 0), cA, voffA); PG8_STAGE(PG8_SA(0, 1), cA + hstep, voffA);
        if (wr == 1) PG8_BAR;
        PG8_WAIT_V(2); PG8_BAR;
        PG8_STAGE(PG8_SB(1, 0), cB + kstep, voffB); PG8_STAGE(PG8_SA(1, 0), cA + kstep, voffA); PG8_STAGE(PG8_SB(1, 1), cB + hstep + kstep, voffB);
        PG8_WAIT_V(6); PG8_BAR;
    } else {
        PG8_STAGE(PG8_SB(0, 0), cB, voffB); PG8_STAGE(PG8_SA(0, 0), cA, voffA); PG8_STAGE(PG8_SB(0, 1), cB + hstep, voffB); PG8_STAGE(PG8_SA(0, 1), cA + hstep, voffA);
        if (wr == 1) PG8_BAR;
        PG8_WAIT_V(4); PG8_BAR;
        PG8_STAGE(PG8_SB(1, 0), cB + kstep, voffB); PG8_STAGE(PG8_SA(1, 0), cA + kstep, voffA); PG8_STAGE(PG8_SB(1, 1), cB + hstep + kstep, voffB);
        PG8_WAIT_V(6); PG8_BAR;
    }
    for (;;) {
        const bool has_next = S.next(ui + 1, nxt);
        const char* nA = has_next ? (const char*)g.A + (size_t)nxt.pm * tstep : cA; const char* nB = has_next ? (const char*)g.Bt + (size_t)nxt.pn * tstep : cB;
        for (int t = 0; t < nt; t += 2) {
            const bool last = (t == nt - 2);
            const char* a1 = cA + (size_t)(t + 1) * kstep;
            const char* a2 = last ? nA : cA + (size_t)(t + 2) * kstep; const char* b2 = last ? nB : cB + (size_t)(t + 2) * kstep;
            const char* a3 = a2 + kstep; const char* b3 = b2 + kstep;
            if (last && has_next) S.a_ready(nxt);
            if constexpr (SP2) {
            PG8_LDB(B0, 0, 0); PG8_LDB(B1, 0, 1); PG8_SCHED; PG8_LDA(At, 0, 0); PG8_STAGE(PG8_SA(1, 1), a1 + hstep, voffA);
            PG8_WAIT_V(8); PG8_WAIT_L(0); PG8_BAR; PG8_MMA(0, 0, At, B0); PG8_MMA(0, 1, At, B1); PG8_BAR; PG8_SCHED;
            PG8_LDA(At, 0, 1); PG8_STAGE(PG8_SB(0, 0), b2, voffB); PG8_STAGE(PG8_SB(0, 1), b2 + hstep, voffB); PG8_STAGE(PG8_SA(0, 0), a2, voffA);
            PG8_WAIT_V(8); PG8_WAIT_L(0); PG8_BAR; PG8_MMA(1, 0, At, B0); PG8_MMA(1, 1, At, B1); PG8_BAR; PG8_SCHED;
            PG8_LDB(B0, 1, 0); PG8_LDB(B1, 1, 1); PG8_SCHED; PG8_LDA(At, 1, 0); PG8_STAGE(PG8_SA(0, 1), a2 + hstep, voffA);
            PG8_WAIT_V(8); PG8_WAIT_L(0); PG8_BAR; PG8_MMA(0, 0, At, B0); PG8_MMA(0, 1, At, B1); PG8_BAR; PG8_SCHED;
            PG8_LDA(At, 1, 1); PG8_STAGE(PG8_SB(1, 0), b3, voffB); PG8_STAGE(PG8_SB(1, 1), b3 + hstep, voffB); PG8_STAGE(PG8_SA(1, 0), a3, voffA);
            PG8_WAIT_V(8); PG8_WAIT_L(0); PG8_BAR; PG8_MMA(1, 0, At, B0); PG8_MMA(1, 1, At, B1); PG8_BAR; PG8_SCHED;
            } else {
            PG8_LDB(B0, 0, 0); PG8_SCHED; PG8_LDA(At, 0, 0); PG8_STAGE(PG8_SA(1, 1), a1 + hstep, voffA);
            PG8_WAIT_L(8); PG8_BAR; PG8_WAIT_L(0); PG8_MMA(0, 0, At, B0); PG8_BAR; PG8_SCHED;
            PG8_LDB(B1, 0, 1); PG8_STAGE(PG8_SB(0, 0), b2, voffB);
            PG8_BAR; PG8_WAIT_L(0); PG8_MMA(0, 1, At, B1); PG8_BAR;
            PG8_LDA(At, 0, 1); PG8_STAGE(PG8_SA(0, 0), a2, voffA);
            PG8_BAR; PG8_WAIT_L(0); PG8_MMA(1, 0, At, B0); PG8_BAR; PG8_SCHED;
            PG8_STAGE(PG8_SB(0, 1), b2 + hstep, voffB);
            PG8_WAIT_V(6); PG8_BAR; PG8_MMA(1, 1, At, B1); PG8_BAR;
            PG8_LDB(B0, 1, 0); PG8_SCHED; PG8_LDA(At, 1, 0); PG8_STAGE(PG8_SA(0, 1), a2 + hstep, voffA);
            PG8_WAIT_L(8); PG8_BAR; PG8_WAIT_L(0); PG8_MMA(0, 0, At, B0); PG8_BAR; PG8_SCHED;
            PG8_LDB(B1, 1, 1); PG8_STAGE(PG8_SB(1, 0), b3, voffB);
            PG8_BAR; PG8_WAIT_L(0); PG8_MMA(0, 1, At, B1); PG8_BAR;
            PG8_LDA(At, 1, 1); PG8_STAGE(PG8_SA(1, 0), a3, voffA);
            PG8_BAR; PG8_WAIT_L(0); PG8_MMA(1, 0, At, B0); PG8_BAR; PG8_SCHED;
            PG8_STAGE(PG8_SB(1, 1), b3 + hstep, voffB);
            PG8_WAIT_V(6); PG8_BAR; PG8_MMA(1, 1, At, B1); PG8_BAR;
            }
        }
        if constexpr (ALIGN_EPI) { if (wr == 0) PG8_BAR; }
        if constexpr (!Epi::AFTER_DRAIN) { E(acc, cur, wr, wc, fr, fq); S.done(cur); }
        if (!has_next) break;
#pragma unroll
        for (int a = 0; a < 2; ++a)
#pragma unroll
            for (int b = 0; b < 2; ++b)
#pragma unroll
                for (int m = 0; m < 4; ++m)
#pragma unroll
                    for (int n = 0; n < 2; ++n) acc[a][b][m][n] = (f32x4){0.f, 0.f, 0.f, 0.f};
        cur = nxt; cA = nA; cB = nB; ++ui;
        if constexpr (ALIGN_EPI) { if (wr == 1) PG8_BAR; }
    }
    PG8_WAIT_V(0);
    if constexpr (!ALIGN_EPI) { if (wr == 0) PG8_BAR; }
    PG8_BAR;
    if constexpr (Epi::AFTER_DRAIN) { E.fused(acc, cur, wr, wc, fr, fq, lds, wid, lane); S.done(cur); }
#undef PG8_SA
#undef PG8_SB
#undef PG8_STAGE
#undef PG8_LDA
#undef PG8_LDB
#undef PG8_MMA
#undef PG8_WAIT_V
#undef PG8_WAIT_L
#undef PG8_BAR
#undef PG8_SCHED
}
}

constexpr int NWAVES = 8;
constexpr int BATCH = 8, SEQ = 4096, DM = 2048, DEPTH = 4, M = BATCH * SEQ;
constexpr int INW = 5376, DFF = 5632, NGU = 2 * DFF, XW = 512, MEML = 256, MROWS = BATCH * MEML;
constexpr int QA = 0, KA = 512, VA = 640, QB = 768, KB = 1280, VB = 1792, QC = 2304, KC = 3328, VC = 4352;
constexpr float LOG2E = 1.4426950408889634f;
constexpr float C2 = 0.125f * LOG2E;
constexpr float CX2 = 0.08838834764831845f * LOG2E;
constexpr float EPS = 1e-5f;

constexpr size_t MiB = 1u << 20;
constexpr size_t WS_CTL = 0, CTL_ZERO_BYTES = 4 * MiB;
constexpr size_t WS_KMEAN = 1 * MiB;
constexpr size_t WS_WL = 4 * MiB, WL_STRIDE = 99 * MiB;
constexpr size_t WL_IN = 0, WL_OUT = 21 * MiB, WL_Q = 29 * MiB, WL_O = 31 * MiB, WL_GU = 33 * MiB, WL_DN = 77 * MiB;
constexpr size_t WS_WKV = 400 * MiB;
constexpr size_t WS_KVX = 416 * MiB;
constexpr size_t WS_XN = 432 * MiB;
constexpr size_t WS_BIG = 560 * MiB;
constexpr size_t WS_QX = WS_XN, WS_OX = WS_XN + 32 * MiB;
constexpr size_t WS_PART = 912 * MiB;
constexpr size_t WS_LSE = WS_PART + 128 * MiB;
constexpr size_t WS_SS = WS_LSE + 6 * MiB, SS_BYTES = 13 * 32768 * 8;
constexpr size_t WS_MEMN = WS_SS + 4 * MiB;
constexpr size_t WS_END = WS_MEMN + 32 * MiB;
static_assert((size_t)INW * DM * 2 == 21 * MiB && (size_t)NGU * DM * 2 == 44 * MiB && (size_t)DM * DFF * 2 == 22 * MiB, "weight map");
static_assert((size_t)M * DFF * 2 == 352 * MiB, "big buffer");
constexpr int CW_TMO = 0;
constexpr int CW_BAR = 4096;
constexpr int RING_OFF = 0, RING_BYTES = 131072;
constexpr int LDSCTL_OFF = RING_BYTES, MISC_OFF = LDSCTL_OFF + 320;
constexpr int LDS_BYTES = 147456;

#define GAS __attribute__((address_space(1)))
#define LAS __attribute__((address_space(3)))
typedef unsigned short bf16;
typedef unsigned v4u __attribute__((ext_vector_type(4)));
typedef unsigned v2u __attribute__((ext_vector_type(2)));
typedef float f32x4 __attribute__((ext_vector_type(4)));
typedef GAS unsigned gu32;
#define RLX_AGENT __ATOMIC_RELAXED, __HIP_MEMORY_SCOPE_AGENT
#define LDS_WAIT() asm volatile("s_waitcnt lgkmcnt(0)" ::: "memory")
__device__ __forceinline__ unsigned f2bf(float f) { unsigned u = __builtin_bit_cast(unsigned, f); return (u + 0x7fffu + ((u >> 16) & 1u)) >> 16; }
typedef float pk_f32x2 __attribute__((ext_vector_type(2)));
typedef __bf16 pk_bf16x2 __attribute__((ext_vector_type(2)));
__device__ __forceinline__ unsigned pk2(float lo, float hi) { pk_f32x2 v = {lo, hi}; return __builtin_bit_cast(unsigned, __builtin_convertvector(v, pk_bf16x2)); }
__device__ __forceinline__ float bflo(unsigned w) { return __builtin_bit_cast(float, w << 16); }
__device__ __forceinline__ float bfhi(unsigned w) { return __builtin_bit_cast(float, w & 0xffff0000u); }
__device__ __forceinline__ float bf1(bf16 x) { return __builtin_bit_cast(float, (unsigned)x << 16); }
__device__ __forceinline__ float ex2(float x) { return __builtin_amdgcn_exp2f(x); }
#define XB_TMO      128
#define XB_XCNT(j)  (256  + 64 * (j))
#define XB_XSUB(j)  (1280 + 64 * (j))
#define XB_XGEN(j)  (2304 + 64 * (j))
#define XB_TOP      3328
#define XB_TOPGEN   3392
#define XCD_BAR_WORDS 3456
#define XB_SPIN_CAP (1u << 18)

__device__ __forceinline__ unsigned xb_ld(unsigned* p)              { return __hip_atomic_load(p, __ATOMIC_RELAXED, __HIP_MEMORY_SCOPE_AGENT); }
__device__ __forceinline__ unsigned xb_add(unsigned* p, unsigned v) { return __hip_atomic_fetch_add(p, v, __ATOMIC_RELAXED, __HIP_MEMORY_SCOPE_AGENT); }
__device__ __forceinline__ unsigned xb_xcc_id() { return (unsigned)__builtin_amdgcn_s_getreg((3 << 11) | 20) & 0xFu; }
#define XB_SPIN(cond, bar) do { unsigned _sp = 0; while (cond) { __builtin_amdgcn_s_sleep(1); \
    if ((++_sp & 255u) == 0u) { if (xb_ld(&(bar)[XB_TMO])) break; if (_sp > XB_SPIN_CAP) { atomicAdd(&(bar)[XB_TMO], 1u); break; } } } } while (0)

struct XcdBarrier {
    unsigned* bar; unsigned x;
    volatile LAS unsigned* st;
};

__device__ __forceinline__ XcdBarrier xcd_barrier_post(unsigned* bar, volatile LAS unsigned* st) {
    XcdBarrier b; b.bar = bar; b.x = xb_xcc_id(); b.st = st;
    if (threadIdx.x == 0) (void)xb_add(&bar[XB_XCNT(b.x)], 1u);
    return b;
}
__device__ __forceinline__ void xcd_barrier_complete(unsigned* bar, unsigned x, unsigned& nloc, unsigned& nx) {
    const unsigned G = gridDim.x * gridDim.y * gridDim.z;
    unsigned sum, cnt, mine, sp = 0u;
    for (;;) {
        sum = 0u; cnt = 0u; mine = 0u;
#pragma unroll
        for (unsigned j = 0; j < 16; ++j) { const unsigned c = xb_ld(&bar[XB_XCNT(j)]); sum += c; cnt += (c > 0u) ? 1u : 0u; mine = (j == x) ? c : mine; }
        if (sum == G) break;
        __builtin_amdgcn_s_sleep(1);
        if ((++sp & 255u) == 0u) { if (xb_ld(&bar[XB_TMO])) break; if (sp > XB_SPIN_CAP) { atomicAdd(&bar[XB_TMO], 1u); break; } }
    }
    nloc = mine > 0u ? mine : 1u; nx = cnt > 0u ? cnt : 1u;
}

__device__ __forceinline__ void xcd_barrier(const XcdBarrier& b) {
    asm volatile("s_waitcnt vmcnt(0)" ::: "memory");
    __syncthreads();
    if (threadIdx.x == 0) {
        unsigned* bar = b.bar;
        __builtin_amdgcn_s_waitcnt(0);
        unsigned nloc = b.st[0], nx = b.st[1];
        if (nloc == 0u) { xcd_barrier_complete(bar, b.x, nloc, nx); b.st[0] = nloc; b.st[1] = nx; }
        const unsigned old = xb_add(&bar[XB_XSUB(b.x)], 1u);
        const unsigned gen = old / nloc;
        if (old + 1u == (gen + 1u) * nloc) {
            __builtin_amdgcn_fence(__ATOMIC_RELEASE, "agent");
            asm volatile("s_waitcnt vmcnt(0)" ::: "memory");
            const unsigned og = xb_add(&bar[XB_TOP], 1u);
            const unsigned tg = og / nx;
            if (og + 1u == (tg + 1u) * nx) xb_add(&bar[XB_TOPGEN], 1u);
            else XB_SPIN(xb_ld(&bar[XB_TOPGEN]) == tg, bar);
            __builtin_amdgcn_fence(__ATOMIC_ACQUIRE, "agent");
            xb_add(&bar[XB_XGEN(b.x)], 1u);
            asm volatile("s_waitcnt vmcnt(0)" ::: "memory");
        } else {
            XB_SPIN(xb_ld(&bar[XB_XGEN(b.x)]) == gen, bar);
            __builtin_amdgcn_fence(__ATOMIC_ACQUIRE, "agent");
            asm volatile("s_waitcnt vmcnt(0)" ::: "memory");
        }
    }
    __syncthreads();
}

__device__ __forceinline__ unsigned xcd_barrier_post_rank(unsigned* bar, unsigned x) { return xb_add(&bar[XB_XCNT(x)], 1u); }
__device__ __forceinline__ void xcd_barrier2(const XcdBarrier& b, const bool team) {
    asm volatile("s_waitcnt vmcnt(0)" ::: "memory");
    __syncthreads();
    if (threadIdx.x == 0) {
        unsigned* bar = b.bar;
        __builtin_amdgcn_s_waitcnt(0);
        unsigned nloc = b.st[0], nx = b.st[1];
        if (nloc == 0u) { xcd_barrier_complete(bar, b.x, nloc, nx); b.st[0] = nloc; b.st[1] = nx; }
        const unsigned old = xb_add(&bar[XB_XSUB(b.x)], 1u);
        const unsigned gen = old / nloc;
        if (old + 1u == (gen + 1u) * nloc) {
            if (!team) {
                __builtin_amdgcn_fence(__ATOMIC_RELEASE, "agent");
                asm volatile("s_waitcnt vmcnt(0)" ::: "memory");
                const unsigned og = xb_add(&bar[XB_TOP], 1u);
                const unsigned tg = og / nx;
                if (og + 1u == (tg + 1u) * nx) xb_add(&bar[XB_TOPGEN], 1u);
                else XB_SPIN(xb_ld(&bar[XB_TOPGEN]) == tg, bar);
            }
            __builtin_amdgcn_fence(__ATOMIC_ACQUIRE, "agent");
            xb_add(&bar[XB_XGEN(b.x)], 1u);
            asm volatile("s_waitcnt vmcnt(0)" ::: "memory");
        } else {
            XB_SPIN(xb_ld(&bar[XB_XGEN(b.x)]) == gen, bar);
            __builtin_amdgcn_fence(__ATOMIC_ACQUIRE, "agent");
            asm volatile("s_waitcnt vmcnt(0)" ::: "memory");
        }
    }
    __syncthreads();
}

__device__ __forceinline__ float wave_sum(float v) {
    return sum_x32(sum_x16(sum_row16(v)));
}
typedef short tr_v4i16 __attribute__((ext_vector_type(4)));
__device__ __forceinline__ void transpose_item(const float* W, int K, int N, bf16* WT, int dst_row0, int k0, int n0, LAS char* scr, int lane, const float* gk = nullptr) {
    const int i16 = lane & 15, g = lane >> 4;
    f32x4 w[16];
#pragma unroll
    for (int i = 0; i < 16; ++i) w[i] = __builtin_nontemporal_load((const GAS f32x4*)(W + (size_t)(k0 + 4 * i + g) * N + n0 + 4 * i16));
#pragma unroll
    for (int i = 0; i < 16; ++i) { const int kk = 4 * i + g; f32x4 x = w[i]; if (gk) x = x * gk[k0 + kk];
        v2u p; p.x = pk2(x.x, x.y); p.y = pk2(x.z, x.w); *(LAS v2u*)(scr + kk * 144 + i16 * 8) = p; }
    LDS_WAIT(); asm volatile("" ::: "memory");
    const int q = i16 >> 2, pp = i16 & 3;
#pragma unroll
    for (int p = 0; p < 8; ++p) { const int c8 = (p & 1) * 4 + g, nb = p >> 1;
        LAS const char* src = scr + (8 * c8 + q) * 144 + nb * 32 + pp * 8;
        const tr_v4i16 lo = __builtin_amdgcn_ds_read_tr16_b64_v4i16((LAS tr_v4i16*)src), hi = __builtin_amdgcn_ds_read_tr16_b64_v4i16((LAS tr_v4i16*)(src + 4 * 144));
        v4u o; const v2u l2 = __builtin_bit_cast(v2u, lo), h2 = __builtin_bit_cast(v2u, hi); o.x = l2.x; o.y = l2.y; o.z = h2.x; o.w = h2.y;
        *(GAS v4u*)(WT + (size_t)(dst_row0 + nb * 16 + i16) * K + k0 + 8 * c8) = o; }
    LDS_WAIT(); asm volatile("" ::: "memory");
}
__device__ __forceinline__ float row_load_ss(const float* xrow, int lane, f32x4 (&v)[8]) {
    const GAS f32x4* xr = (const GAS f32x4*)xrow + lane; float s = 0.f;
#pragma unroll
    for (int j = 0; j < 8; ++j) { v[j] = xr[64 * j]; s += (v[j].x * v[j].x + v[j].y * v[j].y) + (v[j].z * v[j].z + v[j].w * v[j].w); }
    return wave_sum(s);
}
__device__ __forceinline__ void row_store_bf16(bf16* orow, int lane, const f32x4 (&v)[8], const f32x4 (&g)[8], float rstd) {
    GAS unsigned long long* o8 = (GAS unsigned long long*)orow + lane;
#pragma unroll
    for (int j = 0; j < 8; ++j) o8[64 * j] = (unsigned long long)pk2(v[j].x * rstd * g[j].x, v[j].y * rstd * g[j].y) | ((unsigned long long)pk2(v[j].z * rstd * g[j].z, v[j].w * rstd * g[j].w) << 32);
}
__device__ __forceinline__ void load_gain(const float* g, int lane, f32x4 (&gv)[8]) {
    const GAS f32x4* gr = (const GAS f32x4*)g + lane;
#pragma unroll
    for (int j = 0; j < 8; ++j) gv[j] = gr[64 * j];
}
__device__ __forceinline__ void norm_rows_phase(const float* X, const float* g, bf16* XN, int gw, int NGW, int lane) {
    f32x4 gv[8]; load_gain(g, lane, gv);
    for (int m = gw; m < M; m += NGW) { f32x4 v[8]; const float ss = row_load_ss(X + (size_t)m * DM, lane, v);
        const float rstd = 1.f / sqrtf(ss * (1.f / DM) + EPS); row_store_bf16(XN + (size_t)m * DM, lane, v, gv, rstd); }
}

struct Ptrs {
    const float *x, *mem, *norm_mix, *w_in, *sinks, *gain_a, *gain_b, *gain_c, *w_out, *norm_xattn, *norm_mem, *wq_x, *wk_x, *wv_x, *wo_x, *norm_ffn, *w_gate, *w_up, *w_down, *norm_final;
};
constexpr int IT_IN = 32 * 84, IT_OUT = 32 * 32, IT_Q = 32 * 8, IT_O = 8 * 32, IT_G = 32 * 88, IT_DN = 88 * 32;
constexpr int IT_LAYER = IT_IN + IT_OUT + 3 * IT_Q + IT_O + 2 * IT_G + IT_DN;
__device__ __forceinline__ void p0_convert(const Ptrs& P, unsigned char* ws, bf16* H16, LAS char* scr, int gw, int NGW, int lane) {
    for (int it = gw; it < DEPTH * IT_LAYER; it += NGW) {
        const int l = it / IT_LAYER; int r = it % IT_LAYER;
        unsigned char* wl = ws + WS_WL + (size_t)l * WL_STRIDE;
        if (r < IT_IN) { transpose_item(P.w_in + (size_t)l * DM * INW, DM, INW, (bf16*)(wl + WL_IN), (r % 84) * 64, (r / 84) * 64, (r % 84) * 64, scr, lane, P.norm_mix + l * DM); continue; } r -= IT_IN;
        if (r < IT_OUT) { transpose_item(P.w_out + (size_t)l * DM * DM, DM, DM, (bf16*)(wl + WL_OUT), (r % 32) * 64, (r / 32) * 64, (r % 32) * 64, scr, lane); continue; } r -= IT_OUT;
        if (r < IT_Q) { transpose_item(P.wq_x + (size_t)l * DM * XW, DM, XW, (bf16*)(wl + WL_Q), (r % 8) * 64, (r / 8) * 64, (r % 8) * 64, scr, lane, P.norm_xattn + l * DM); continue; } r -= IT_Q;
        if (r < IT_Q) { transpose_item(P.wk_x + (size_t)l * DM * XW, DM, XW, (bf16*)(ws + WS_WKV) + (size_t)l * 1024 * DM, (r % 8) * 64, (r / 8) * 64, (r % 8) * 64, scr, lane); continue; } r -= IT_Q;
        if (r < IT_Q) { transpose_item(P.wv_x + (size_t)l * DM * XW, DM, XW, (bf16*)(ws + WS_WKV) + (size_t)l * 1024 * DM, 512 + (r % 8) * 64, (r / 8) * 64, (r % 8) * 64, scr, lane); continue; } r -= IT_Q;
        if (r < IT_O) { transpose_item(P.wo_x + (size_t)l * XW * DM, XW, DM, (bf16*)(wl + WL_O), (r % 32) * 64, (r / 32) * 64, (r % 32) * 64, scr, lane); continue; } r -= IT_O;
        if (r < IT_G) { const int n0 = (r % 88) * 64; transpose_item(P.w_gate + (size_t)l * DM * DFF, DM, DFF, (bf16*)(wl + WL_GU), 256 * (n0 >> 7) + (n0 & 127), (r / 88) * 64, n0, scr, lane, P.norm_ffn + l * DM); continue; } r -= IT_G;
        if (r < IT_G) { const int n0 = (r % 88) * 64; transpose_item(P.w_up + (size_t)l * DM * DFF, DM, DFF, (bf16*)(wl + WL_GU), 256 * (n0 >> 7) + 128 + (n0 & 127), (r / 88) * 64, n0, scr, lane, P.norm_ffn + l * DM); continue; } r -= IT_G;
        transpose_item(P.w_down + (size_t)l * DFF * DM, DFF, DM, (bf16*)(wl + WL_DN), (r % 32) * 64, (r / 32) * 64, (r % 32) * 64, scr, lane);
    }
    for (int m = gw; m < MROWS; m += NGW) { f32x4 v[8]; const float ss = row_load_ss(P.mem + (size_t)m * DM, lane, v); const float rstd = 1.f / sqrtf(ss * (1.f / DM) + EPS);
        for (int l = 0; l < DEPTH; ++l) { f32x4 gv[8]; load_gain(P.norm_mem + l * DM, lane, gv); row_store_bf16((bf16*)(ws + WS_MEMN) + ((size_t)l * MROWS + m) * DM, lane, v, gv, rstd); } }
    { unsigned long long* ss0 = (unsigned long long*)(ws + WS_SS); f32x4 one[8];
#pragma unroll
      for (int j = 0; j < 8; ++j) one[j] = (f32x4){1.f, 1.f, 1.f, 1.f};
      for (int m = gw; m < M; m += 2 * NGW) { f32x4 v[2][8];
#pragma unroll
          for (int q = 0; q < 2; ++q) { const GAS f32x4* xr = (const GAS f32x4*)(P.x + (size_t)(m + q * NGW) * DM) + lane;
#pragma unroll
              for (int j = 0; j < 8; ++j) v[q][j] = xr[64 * j]; }
#pragma unroll
          for (int q = 0; q < 2; ++q) { const int mq = m + q * NGW; float s = 0.f;
#pragma unroll
              for (int j = 0; j < 8; ++j) s += (v[q][j].x * v[q][j].x + v[q][j].y * v[q][j].y) + (v[q][j].z * v[q][j].z + v[q][j].w * v[q][j].w);
              const float ss = wave_sum(s); row_store_bf16(H16 + (size_t)mq * DM, lane, v[q], one, 1.f);
              if (lane == 0) { const unsigned hi_ = (unsigned)ss, lo_ = (unsigned)((ss - (float)hi_) * 4294967296.f); ss0[mq] = ((unsigned long long)hi_ << 32) | lo_; } } } }
}

__device__ __forceinline__ void kmean_phase(const bf16* PJ, float* KM, int gw, int NGW, int lane) {
    for (int it = gw; it < (M / 256) * 8; it += NGW) { const int pm = it >> 3, h = it & 7; const bf16* p = PJ + (size_t)pm * 256 * INW + KB + h * 64 + lane; float s = 0.f;
#pragma unroll 8
        for (int r = 0; r < 256; ++r) s += bf1(p[(size_t)r * INW]);
        KM[pm * 512 + h * 64 + lane] = s; }
}

__device__ __forceinline__ float dot8(v4u a, v4u b, float acc) {
    acc = fmaf(bflo(a.x), bflo(b.x), acc); acc = fmaf(bfhi(a.x), bfhi(b.x), acc); acc = fmaf(bflo(a.y), bflo(b.y), acc); acc = fmaf(bfhi(a.y), bfhi(b.y), acc);
    acc = fmaf(bflo(a.z), bflo(b.z), acc); acc = fmaf(bfhi(a.z), bfhi(b.z), acc); acc = fmaf(bflo(a.w), bflo(b.w), acc); acc = fmaf(bfhi(a.w), bfhi(b.w), acc); return acc;
}
struct Soft64 { float m, l; float o[64]; };
#define SOFT64_KEY(S, sc_, vrow_) do { const float _sc = (sc_); if (_sc > S.m) { const float _a = ex2(S.m - _sc); S.l *= _a; _Pragma("unroll") for (int _d = 0; _d < 64; ++_d) S.o[_d] *= _a; S.m = _sc; } \
    const float _p = ex2(_sc - S.m); S.l += _p; const GAS v4u* _v = (const GAS v4u*)(vrow_); \
    _Pragma("unroll") for (int _i = 0; _i < 8; ++_i) { const v4u _w = _v[_i]; S.o[8 * _i + 0] = fmaf(_p, bflo(_w.x), S.o[8 * _i + 0]); S.o[8 * _i + 1] = fmaf(_p, bfhi(_w.x), S.o[8 * _i + 1]); \
        S.o[8 * _i + 2] = fmaf(_p, bflo(_w.y), S.o[8 * _i + 2]); S.o[8 * _i + 3] = fmaf(_p, bfhi(_w.y), S.o[8 * _i + 3]); S.o[8 * _i + 4] = fmaf(_p, bflo(_w.z), S.o[8 * _i + 4]); S.o[8 * _i + 5] = fmaf(_p, bfhi(_w.z), S.o[8 * _i + 5]); \
        S.o[8 * _i + 6] = fmaf(_p, bflo(_w.w), S.o[8 * _i + 6]); S.o[8 * _i + 7] = fmaf(_p, bfhi(_w.w), S.o[8 * _i + 7]); } } while (0)
#define QK64(qw_, krow_, out_) do { const GAS v4u* _k = (const GAS v4u*)(krow_); float _a0 = 0.f, _a1 = 0.f; _Pragma("unroll") for (int _i = 0; _i < 8; _i += 2) { _a0 = dot8(qw_[_i], _k[_i], _a0); _a1 = dot8(qw_[_i + 1], _k[_i + 1], _a1); } out_ = _a0 + _a1; } while (0)
#define STORE_O64(S, orow_) do { const float _rl = 1.f / S.l; GAS v4u* _o = (GAS v4u*)(orow_); _Pragma("unroll") for (int _i = 0; _i < 8; ++_i) { v4u _w; _w.x = pk2(S.o[8 * _i] * _rl, S.o[8 * _i + 1] * _rl); _w.y = pk2(S.o[8 * _i + 2] * _rl, S.o[8 * _i + 3] * _rl); \
        _w.z = pk2(S.o[8 * _i + 4] * _rl, S.o[8 * _i + 5] * _rl); _w.w = pk2(S.o[8 * _i + 6] * _rl, S.o[8 * _i + 7] * _rl); _o[_i] = _w; } } while (0)

__device__ __forceinline__ void naive_attn_a(const bf16* PJ, const float* sinks, bf16* O, int gtid, int nthr) {
    for (int it = gtid; it < 8 * M; it += nthr) { const int h = it / M, m = it % M, t = m & (SEQ - 1), kvh = h >> 2;
        v4u qw[8]; { const GAS v4u* q = (const GAS v4u*)(PJ + (size_t)m * INW + QA + h * 64);
#pragma unroll
            for (int i = 0; i < 8; ++i) qw[i] = q[i]; }
        const float slope2 = ex2(-(float)(h + 1)) * LOG2E;
        Soft64 S; S.m = sinks[h] * LOG2E; S.l = 1.f;
#pragma unroll
        for (int d = 0; d < 64; ++d) S.o[d] = 0.f;
        const int nk = t < 127 ? t + 1 : 128;
        for (int dist = 0; dist < nk; ++dist) { const bf16* kr = PJ + (size_t)(m - dist) * INW + KA + kvh * 64; float sc; QK64(qw, kr, sc); sc -= slope2 * (float)dist;
            SOFT64_KEY(S, sc, kr + (VA - KA)); }
        STORE_O64(S, O + (size_t)m * DM + h * 64); }
}
__device__ __forceinline__ void naive_attn_b(const bf16* PJ, const float* KM, bf16* O, int gtid, int nthr) {
    for (int it = gtid; it < 8 * M; it += nthr) { const int h = it / M, m = it % M, t = m & (SEQ - 1), blk = t >> 8, pm0 = (m >> 12) << 4;
        v4u qw[8]; { const GAS v4u* q = (const GAS v4u*)(PJ + (size_t)m * INW + QB + h * 64);
#pragma unroll
            for (int i = 0; i < 8; ++i) qw[i] = q[i]; }
        const float slope2 = ex2(-(float)(h + 1)) * LOG2E;
        float g1 = -INFINITY, g2 = -INFINITY, g3 = -INFINITY; int i1 = -1, i2 = -1, i3 = -1;
        for (int n = 0; n < blk; ++n) { const GAS f32x4* km = (const GAS f32x4*)(KM + (size_t)(pm0 + n) * 512 + h * 64); float g = 0.f;
#pragma unroll
            for (int i = 0; i < 8; ++i) { const f32x4 a = km[2 * i], b = km[2 * i + 1]; const v4u w = qw[i];
                g = fmaf(bflo(w.x), a.x, g); g = fmaf(bfhi(w.x), a.y, g); g = fmaf(bflo(w.y), a.z, g); g = fmaf(bfhi(w.y), a.w, g);
                g = fmaf(bflo(w.z), b.x, g); g = fmaf(bfhi(w.z), b.y, g); g = fmaf(bflo(w.w), b.z, g); g = fmaf(bfhi(w.w), b.w, g); }
            if (g > g1) { g3 = g2; i3 = i2; g2 = g1; i2 = i1; g1 = g; i1 = n; } else if (g > g2) { g3 = g2; i3 = i2; g2 = g; i2 = n; } else if (g > g3) { g3 = g; i3 = n; } }
        Soft64 S; S.m = -1e30f; S.l = 0.f;
#pragma unroll
        for (int d = 0; d < 64; ++d) S.o[d] = 0.f;
        const int mb = m - t;
        for (int s = 0; s < 4; ++s) { const int n = (s == 0) ? blk : (s == 1 ? i1 : (s == 2 ? i2 : i3)); if (n < 0) continue;
            const int p0 = n * 256, nk = (s == 0) ? (t - p0 + 1) : 256;
            for (int j = 0; j < nk; ++j) { const int pos = p0 + j; const bf16* kr = PJ + (size_t)(mb + pos) * INW + KB + h * 64; float sc; QK64(qw, kr, sc); sc -= slope2 * (float)(t - pos);
                SOFT64_KEY(S, sc, kr + (VB - KB)); } }
        STORE_O64(S, O + (size_t)m * DM + 512 + h * 64); }
}
__device__ __forceinline__ void naive_attn_c(const bf16* PJ, bf16* O, int gtid, int nthr) {
    for (int it = gtid; it < 16 * M; it += nthr) { const int h = it / M, m = it % M, t = m & (SEQ - 1);
        v4u qw[8]; { const GAS v4u* q = (const GAS v4u*)(PJ + (size_t)m * INW + QC + h * 64);
#pragma unroll
            for (int i = 0; i < 8; ++i) qw[i] = q[i]; }
        const float slope2 = ex2(-0.5f * (float)(h + 1)) * LOG2E;
        Soft64 S; S.m = -1e30f; S.l = 0.f;
#pragma unroll
        for (int d = 0; d < 64; ++d) S.o[d] = 0.f;
        for (int br = 0; br < 3; ++br) { const int dd = (br == 0) ? 1 : (br == 1 ? 4 : 16);
            for (int step = 0; step <= 128; ++step) { const int dist = step * dd; if (dist > t) break;
                const bf16* kr = PJ + (size_t)(m - dist) * INW + KC + h * 64; float sc; QK64(qw, kr, sc); sc -= slope2 * (float)dist;
                SOFT64_KEY(S, sc, kr + (VC - KC)); } }
        STORE_O64(S, O + (size_t)m * DM + 1024 + h * 64); }
}
__device__ __forceinline__ void naive_attn_x(const bf16* QX, const bf16* KVX  , bf16* OX, int gtid, int nthr) {
    for (int it = gtid; it < 8 * M; it += nthr) { const int hh = it / M, m = it % M, h = hh >> 1, half = hh & 1, b = m >> 12;
        v4u qw[16]; { const GAS v4u* q = (const GAS v4u*)(QX + (size_t)m * XW + h * 128);
#pragma unroll
            for (int i = 0; i < 16; ++i) qw[i] = q[i]; }
        Soft64 S; S.m = -1e30f; S.l = 0.f;
#pragma unroll
        for (int d = 0; d < 64; ++d) S.o[d] = 0.f;
        for (int j = 0; j < MEML; ++j) { const bf16* kr = KVX + (size_t)(b * MEML + j) * 1024 + h * 128; const GAS v4u* k = (const GAS v4u*)kr; float a0 = 0.f, a1 = 0.f;
#pragma unroll
            for (int i = 0; i < 16; i += 2) { a0 = dot8(qw[i], k[i], a0); a1 = dot8(qw[i + 1], k[i + 1], a1); }
            SOFT64_KEY(S, a0 + a1, kr + 512 + half * 64); }
        STORE_O64(S, OX + (size_t)m * XW + h * 128 + half * 64); }
}
template <bool MERGE>
__device__ __forceinline__ void ynorm_phase(bf16* Y, bf16* YO  , const bf16* PART, const float* LSE, const float* ga, const float* gb, const float* gc, int row_lo, int row_hi, int row_step, int lane) {
    f32x4 g[4][2];
#pragma unroll
    for (int j = 0; j < 4; ++j) { const float* gp = (j == 0) ? ga : (j == 1 ? gb : gc + (j - 2) * 512); g[j][0] = *(const GAS f32x4*)(gp + 8 * lane); g[j][1] = *(const GAS f32x4*)(gp + 8 * lane + 4); }
    struct YR { v4u w[4], p1[2], p2[2]; float l0[2], l1[2], l2[2]; };
    auto load = [&](YR& R, int m) { GAS v4u* row = (GAS v4u*)(Y + (size_t)m * DM) + lane;
#pragma unroll
        for (int j = 0; j < 4; ++j) R.w[j] = row[64 * j];
        if (MERGE) {
#pragma unroll
            for (int jj = 0; jj < 2; ++jj) { const int hc = 8 * jj + (lane >> 3); R.l0[jj] = LSE[(size_t)m * 16 + hc]; R.l1[jj] = LSE[(size_t)(M + m) * 16 + hc]; R.l2[jj] = LSE[(size_t)(2 * M + m) * 16 + hc];
                R.p1[jj] = *(const GAS v4u*)(PART + (size_t)m * 1024 + 512 * jj + 8 * lane); R.p2[jj] = *(const GAS v4u*)(PART + (size_t)(M + m) * 1024 + 512 * jj + 8 * lane); } } };
    auto finish = [&](const YR& R, int m) { float v[4][8], ss[4];
#pragma unroll
        for (int j = 0; j < 4; ++j) { const v4u w = R.w[j]; v[j][0] = bflo(w.x); v[j][1] = bfhi(w.x); v[j][2] = bflo(w.y); v[j][3] = bfhi(w.y); v[j][4] = bflo(w.z); v[j][5] = bfhi(w.z); v[j][6] = bflo(w.w); v[j][7] = bfhi(w.w);
            if (MERGE && j >= 2) { const float l0 = R.l0[j - 2], l1 = R.l1[j - 2], l2 = R.l2[j - 2];
                const float mx = fmaxf(l0, fmaxf(l1, l2)), e0 = ex2(l0 - mx), e1 = ex2(l1 - mx), e2 = ex2(l2 - mx), ri = 1.f / (e0 + e1 + e2);
                const v4u w1 = R.p1[j - 2], w2 = R.p2[j - 2];
                const float a0 = e0 * ri, a1 = e1 * ri, a2 = e2 * ri;
                v[j][0] = a0 * v[j][0] + a1 * bflo(w1.x) + a2 * bflo(w2.x); v[j][1] = a0 * v[j][1] + a1 * bfhi(w1.x) + a2 * bfhi(w2.x);
                v[j][2] = a0 * v[j][2] + a1 * bflo(w1.y) + a2 * bflo(w2.y); v[j][3] = a0 * v[j][3] + a1 * bfhi(w1.y) + a2 * bfhi(w2.y);
                v[j][4] = a0 * v[j][4] + a1 * bflo(w1.z) + a2 * bflo(w2.z); v[j][5] = a0 * v[j][5] + a1 * bfhi(w1.z) + a2 * bfhi(w2.z);
                v[j][6] = a0 * v[j][6] + a1 * bflo(w1.w) + a2 * bflo(w2.w); v[j][7] = a0 * v[j][7] + a1 * bfhi(w1.w) + a2 * bfhi(w2.w); }
            float s = 0.f;
#pragma unroll
            for (int e = 0; e < 8; ++e) s += v[j][e] * v[j][e];
            ss[j] = wave_sum(s); }
        const float ra = 1.f / sqrtf(ss[0] * (1.f / 512) + EPS), rb = 1.f / sqrtf(ss[1] * (1.f / 512) + EPS), rc = 1.f / sqrtf((ss[2] + ss[3]) * (1.f / 1024) + EPS);
#pragma unroll
        for (int j = 0; j < 4; ++j) { const float r = (j == 0) ? ra : (j == 1 ? rb : rc); v4u w;
            w.x = pk2(v[j][0] * r * g[j][0].x, v[j][1] * r * g[j][0].y); w.y = pk2(v[j][2] * r * g[j][0].z, v[j][3] * r * g[j][0].w);
            w.z = pk2(v[j][4] * r * g[j][1].x, v[j][5] * r * g[j][1].y); w.w = pk2(v[j][6] * r * g[j][1].z, v[j][7] * r * g[j][1].w); ((GAS v4u*)(YO + (size_t)m * DM) + lane)[64 * j] = w; } };
    for (int m = row_lo; m < row_hi; m += 2 * row_step) { YR R[2];
#pragma unroll
        for (int q = 0; q < 2; ++q) if (m + q * row_step < row_hi) load(R[q], m + q * row_step);
#pragma unroll
        for (int q = 0; q < 2; ++q) if (m + q * row_step < row_hi) finish(R[q], m + q * row_step); }
}

namespace att {
typedef float f32x16 __attribute__((ext_vector_type(16)));
typedef float f32x2_t __attribute__((ext_vector_type(2)));
typedef __bf16 bf16x2_t __attribute__((ext_vector_type(2)));
typedef short bf16x8 __attribute__((ext_vector_type(8)));
typedef short s16x4 __attribute__((ext_vector_type(4)));
typedef short v4i16_t __attribute__((ext_vector_type(4)));
#define ATT_MFMA(a, b, c) __builtin_amdgcn_mfma_f32_32x32x16_bf16(a, b, c, 0, 0, 0)
constexpr float THR = 8.f;
constexpr float NEG = -1e30f;
__device__ __forceinline__ unsigned cvtpk(float lo, float hi) { f32x2_t v = {lo, hi}; bf16x2_t b = __builtin_convertvector(v, bf16x2_t); return __builtin_bit_cast(unsigned, b); }
__device__ __forceinline__ s16x4 vtr(LAS const char* p) { return __builtin_bit_cast(s16x4, __builtin_amdgcn_ds_read_tr16_b64_v4i16((LAS v4i16_t*)p)); }
__device__ __forceinline__ float swapmax(float m) { float a, b; swap32(m, a, b); return fmaxf(a, b); }
__device__ __forceinline__ float swapsum(float m) { float a, b; swap32(m, a, b); return a + b; }
__device__ __forceinline__ int crowc(int r) { return (r & 3) + 8 * (r >> 2); }

template <int NKD> struct St { f32x16 o[NKD / 2]; float m, l; };

struct Mask { int on, sgn, thr; };
__device__ __forceinline__ Mask mk_none() { return Mask{0, 1, 0}; }
__device__ __forceinline__ Mask mk_diag() { return Mask{1, -1, 0}; }
__device__ __forceinline__ Mask mk_far(int incl) { return Mask{1, 1, incl ? 0 : 1}; }

template <int NKD>
__device__ __forceinline__ void step(St<NKD>& s, const bf16x8 (&qf)[NKD], const bf16x8 (&kf)[NKD], LAS const char* vimg, const f32x16& kbc, float tb, bool sel, const Mask mk, int r32, int hi) {
    f32x16 S = kbc;
#pragma unroll
    for (int i = 0; i < NKD; ++i) S = ATT_MFMA(kf[i], qf[i], S);
    if (mk.on) { const int sv = mk.sgn * (4 * hi - r32);
#pragma unroll
        for (int r = 0; r < 16; ++r) S[r] = (sv >= mk.thr - mk.sgn * crowc(r)) ? S[r] : NEG; }
    float mx = fmaxf(fmaxf(S[0], S[1]), fmaxf(S[2], S[3]));
#pragma unroll
    for (int r = 4; r < 16; r += 4) mx = fmaxf(mx, fmaxf(fmaxf(S[r], S[r + 1]), fmaxf(S[r + 2], S[r + 3])));
    mx = swapmax(mx);
    const float tmax = sel ? mx + tb : NEG;
    if (__any(tmax > s.m + THR)) { const float mn = fmaxf(s.m, tmax), a = ex2(s.m - mn); s.l *= a; s.m = mn;
#pragma unroll
        for (int c = 0; c < NKD / 2; ++c) s.o[c] *= a; }
    const float cm = sel ? tb - s.m : -INFINITY;
    float ps = 0.f;
#pragma unroll
    for (int r = 0; r < 16; ++r) { S[r] = ex2(S[r] + cm); ps += S[r]; }
    s.l += ps;
    v4u pw0, pw1;
    pw0.x = cvtpk(S[0], S[1]); pw0.y = cvtpk(S[2], S[3]); pw0.z = cvtpk(S[4], S[5]); pw0.w = cvtpk(S[6], S[7]);
    pw1.x = cvtpk(S[8], S[9]); pw1.y = cvtpk(S[10], S[11]); pw1.z = cvtpk(S[12], S[13]); pw1.w = cvtpk(S[14], S[15]);
    const bf16x8 pa0 = __builtin_bit_cast(bf16x8, pw0), pa1 = __builtin_bit_cast(bf16x8, pw1);
#pragma unroll
    for (int c = 0; c < NKD / 2; ++c) {
        const s16x4 a0 = vtr(vimg + c * 2048), a1 = vtr(vimg + c * 2048 + 512), b0 = vtr(vimg + c * 2048 + 1024), b1 = vtr(vimg + c * 2048 + 1536);
        const bf16x8 v0 = {a0[0], a0[1], a0[2], a0[3], a1[0], a1[1], a1[2], a1[3]}, v1 = {b0[0], b0[1], b0[2], b0[3], b1[0], b1[1], b1[2], b1[3]};
        s.o[c] = ATT_MFMA(v0, pa0, s.o[c]); s.o[c] = ATT_MFMA(v1, pa1, s.o[c]); }
}

template <int NKD> __device__ __forceinline__ void load_k(bf16x8 (&kf)[NKD], const bf16* krow) {
#pragma unroll
    for (int i = 0; i < NKD; ++i) kf[i] = *(const GAS bf16x8*)(krow + 16 * i); }
template <int NKD> __device__ __forceinline__ void load_v(v4u (&vr)[NKD], const bf16* vrow  , long rs16  ) {
#pragma unroll
    for (int p = 0; p < NKD; ++p) vr[p] = *(const GAS v4u*)(vrow + (p & 1) * rs16 + (p >> 1) * 32); }
template <int NKD> __device__ __forceinline__ void write_v(const v4u (&vr)[NKD], LAS char* vbuf, int lane) {
#pragma unroll
    for (int p = 0; p < NKD; ++p) *(LAS v4u*)(vbuf + p * 1024 + lane * 16) = vr[p]; }

template <int NKD, bool PREF>
__device__ __forceinline__ void run_tiles(St<NKD>& s, const bf16x8 (&qf)[NKD], const bf16* krow, const bf16* vrow, long rs16, long tstep, int nt, const f32x16& kbc, float tb0, float dtb, bool sel,
                                          const Mask m0, const Mask mfar, LAS char* vl, int lane) {
    const int r32 = lane & 31, hi = lane >> 5;
    const int troff = ((lane >> 4) & 1) * 32 + (lane & 3) * 8 + (4 * hi + ((lane & 15) >> 2)) * 64;
    bf16x8 kf[NKD]; v4u vr[NKD];
    load_k<NKD>(kf, krow); load_v<NKD>(vr, vrow, rs16); write_v<NKD>(vr, vl, lane);
    int buf = 0;
    for (int k = 0; k < nt; ++k) {
        const Mask mk = (k == 0) ? m0 : ((k == 4) ? mfar : mk_none());
        const float tb = tb0 + (float)k * dtb;
        if constexpr (PREF) {
            bf16x8 kn[NKD];
            const bool more = (k + 1 < nt);
            const bf16* kr2 = more ? krow + (long)(k + 1) * tstep : krow; const bf16* vr2 = more ? vrow + (long)(k + 1) * tstep : vrow;
            load_k<NKD>(kn, kr2); load_v<NKD>(vr, vr2, rs16);
            step<NKD>(s, qf, kf, vl + buf * (NKD * 1024) + troff, kbc, tb, sel, mk, r32, hi);
            buf ^= 1; write_v<NKD>(vr, vl + buf * (NKD * 1024), lane);
#pragma unroll
            for (int i = 0; i < NKD; ++i) kf[i] = kn[i];
        } else {
            step<NKD>(s, qf, kf, vl + troff, kbc, tb, sel, mk, r32, hi);
            if (k + 1 < nt) { load_k<NKD>(kf, krow + (long)(k + 1) * tstep); load_v<NKD>(vr, vrow + (long)(k + 1) * tstep, rs16); write_v<NKD>(vr, vl, lane); }
        }
    }
}

template <int NKD> __device__ __forceinline__ void st_init(St<NKD>& s, float m, float l) { s.m = m; s.l = l;
#pragma unroll
    for (int c = 0; c < NKD / 2; ++c)
#pragma unroll
        for (int r = 0; r < 16; ++r) s.o[c][r] = 0.f; }
template <int NKD> __device__ __forceinline__ void st_store(const St<NKD>& s, float rl, bf16* orow  , int hi) {
#pragma unroll
    for (int c = 0; c < NKD / 2; ++c)
#pragma unroll
        for (int g = 0; g < 4; ++g) { v2u w; w.x = cvtpk(s.o[c][4 * g] * rl, s.o[c][4 * g + 1] * rl); w.y = cvtpk(s.o[c][4 * g + 2] * rl, s.o[c][4 * g + 3] * rl);
            *(GAS v2u*)(orow + 32 * c + 8 * g + 4 * hi) = w; }
}
template <int NKD, class RowPtr> __device__ __forceinline__ void st_store_lds(const St<NKD>& s, float rl, LAS char* stg, int lane, RowPtr rowptr) {
    const int r32 = lane & 31, hi = lane >> 5; constexpr int ROWB = NKD * 32;
#pragma unroll
    for (int c = 0; c < NKD / 2; ++c)
#pragma unroll
        for (int g = 0; g < 4; ++g) { v2u w; w.x = cvtpk(s.o[c][4 * g] * rl, s.o[c][4 * g + 1] * rl); w.y = cvtpk(s.o[c][4 * g + 2] * rl, s.o[c][4 * g + 3] * rl);
            *(LAS v2u*)(stg + r32 * ROWB + (((8 * c + 2 * g + hi) ^ (r32 & 15)) << 3)) = w; }
    constexpr int LPR = NKD * 2  , RPP = 64 / LPR  ;
#pragma unroll
    for (int j = 0; j < 32 / RPP; ++j) { const int row = lane / LPR + RPP * j, ch = lane % LPR;
        const v2u a0 = *(const LAS v2u*)(stg + row * ROWB + (((2 * ch) ^ (row & 15)) << 3)), a1 = *(const LAS v2u*)(stg + row * ROWB + (((2 * ch + 1) ^ (row & 15)) << 3));
        v4u w; w.x = a0.x; w.y = a0.y; w.z = a1.x; w.w = a1.y;
        *(GAS v4u*)(rowptr(row) + ch * 8) = w; }
}
template <int NKD> __device__ __forceinline__ void load_q(bf16x8 (&qf)[NKD], const bf16* qrow  ) {
#pragma unroll
    for (int i = 0; i < NKD; ++i) qf[i] = *(const GAS bf16x8*)(qrow + 16 * i); }
__device__ __forceinline__ void make_kbc(f32x16& kbc, float sl  , int hi) {
#pragma unroll
    for (int r = 0; r < 16; ++r) kbc[r] = sl * (float)(crowc(r) + 4 * hi); }

__device__ __forceinline__ void band_item(const bf16* PJ, int brow, int qt0, int dd, int ut, int qcol, int kcol, int vcol, float slope2, int mode, float sink2,
                                          bf16* out  , int opitch, float* lse  , int lpitch, LAS char* vl, int lane) {
    const int r32 = lane & 31, hi = lane >> 5;
    bf16x8 qf[4]; load_q<4>(qf, PJ + (size_t)(brow + qt0 + r32 * dd) * INW + qcol + 8 * hi);
    const float sl = slope2 * (float)dd; f32x16 kbc; make_kbc(kbc, sl, hi);
    St<4> s; if (mode == 0) st_init<4>(s, sink2 + sl * (float)r32, hi == 0 ? 1.f : 0.f); else st_init<4>(s, NEG, 0.f);
    const int nt = (ut + 1 < 5) ? ut + 1 : 5;
    const bf16* t0 = PJ + (size_t)(brow + qt0) * INW;
    const long rs = (long)dd * INW;
    run_tiles<4, true>(s, qf, t0 + (long)r32 * rs + kcol + 8 * hi, t0 + (long)(lane >> 2) * rs + vcol + 8 * (lane & 3), 16 * rs, -32 * rs, nt, kbc, 0.f, -32.f * sl, true, mk_diag(), mk_far(mode), vl, lane);
    const float lt = swapsum(s.l), rl = 1.f / lt;
    st_store<4>(s, rl, out + (size_t)(brow + qt0 + r32 * dd) * opitch, hi);
    if (lse && hi == 0) lse[(size_t)(brow + qt0 + r32 * dd) * lpitch] = s.m + __builtin_amdgcn_logf(lt) - sl * (float)r32;
}

__device__ __forceinline__ void moba_item(const bf16* PJ, const float* KM, int b, int h, int blk, int w, bf16* O, LAS char* vl, int lane) {
    const int r32 = lane & 31, hi = lane >> 5, brow = b * SEQ, q0 = blk * 256 + 32 * w;
    bf16x8 qf[4]; load_q<4>(qf, PJ + (size_t)(brow + q0 + r32) * INW + QB + h * 64 + 8 * hi);
    const float slope2 = ex2(-(float)(h + 1)) * LOG2E; f32x16 kbc; make_kbc(kbc, slope2, hi);
    float g1 = -INFINITY, g2 = -INFINITY, g3 = -INFINITY; int i1 = -1, i2 = -1, i3 = -1;
    for (int n = 0; n < blk; ++n) { const float* km = KM + (size_t)(b * 16 + n) * 512 + h * 64 + 8 * hi; float g = 0.f;
#pragma unroll
        for (int i = 0; i < 4; ++i) { const f32x4 a = *(const GAS f32x4*)(km + 16 * i), c = *(const GAS f32x4*)(km + 16 * i + 4); const v4u wq = __builtin_bit_cast(v4u, qf[i]);
            g = fmaf(bflo(wq.x), a.x, g); g = fmaf(bfhi(wq.x), a.y, g); g = fmaf(bflo(wq.y), a.z, g); g = fmaf(bfhi(wq.y), a.w, g);
            g = fmaf(bflo(wq.z), c.x, g); g = fmaf(bfhi(wq.z), c.y, g); g = fmaf(bflo(wq.w), c.z, g); g = fmaf(bfhi(wq.w), c.w, g); }
        g = swapsum(g);
        if (g > g1) { g3 = g2; i3 = i2; g2 = g1; i2 = i1; g1 = g; i1 = n; } else if (g > g2) { g3 = g2; i3 = i2; g2 = g; i2 = n; } else if (g > g3) { g3 = g; i3 = n; } }
    unsigned selmask = 0u; if (i1 >= 0) selmask |= 1u << i1; if (i2 >= 0) selmask |= 1u << i2; if (i3 >= 0) selmask |= 1u << i3;
    St<4> s; st_init<4>(s, NEG, 0.f);
    const bf16* t0 = PJ + (size_t)(brow + q0) * INW;
    const long rs = INW;
    run_tiles<4, true>(s, qf, t0 + (long)r32 * rs + KB + h * 64 + 8 * hi, t0 + (long)(lane >> 2) * rs + VB + h * 64 + 8 * (lane & 3), 16 * rs, -32 * rs, w + 1, kbc, 0.f, -32.f * slope2, true, mk_diag(), mk_none(), vl, lane);
    for (int n = blk - 1; n >= 0; --n) { const bool sel = (selmask >> n) & 1u; if (!__any(sel)) continue;
        const long off = (long)((n - blk) * 256 + 224 - 32 * w) * rs;
        run_tiles<4, true>(s, qf, t0 + off + (long)r32 * rs + KB + h * 64 + 8 * hi, t0 + off + (long)(lane >> 2) * rs + VB + h * 64 + 8 * (lane & 3), 16 * rs, -32 * rs, 8, kbc,
                           slope2 * (float)((n - blk) * 256 + 224 - 32 * w), -32.f * slope2, sel, mk_none(), mk_none(), vl, lane); }
    const float rl = 1.f / swapsum(s.l);
    st_store<4>(s, rl, O + (size_t)(brow + q0 + r32) * DM + 512 + h * 64, hi);
}

__device__ __forceinline__ void xattn_item(const bf16* QX, const bf16* KVX  , int b, int h, int qt, bf16* OX, LAS char* vl, int lane) {
    const int r32 = lane & 31, hi = lane >> 5;
    bf16x8 qf[8]; load_q<8>(qf, QX + (size_t)(b * SEQ + qt * 32 + r32) * XW + h * 128 + 8 * hi);
    f32x16 kbc;
#pragma unroll
    for (int r = 0; r < 16; ++r) kbc[r] = 0.f;
    St<8> s; st_init<8>(s, NEG, 0.f);
    const bf16* t0 = KVX + (size_t)(b * MEML) * 1024 + h * 128;
    run_tiles<8, false>(s, qf, t0 + (long)r32 * 1024 + 8 * hi, t0 + (long)(lane >> 2) * 1024 + 512 + 8 * (lane & 3), 16 * 1024, 32 * 1024, 8, kbc, 0.f, 0.f, true, mk_none(), mk_none(), vl, lane);
    const float rl = 1.f / swapsum(s.l);
    bf16* ob = OX + (size_t)(b * SEQ + qt * 32) * XW + h * 128;
    st_store_lds<8>(s, rl, vl + 8192, lane, [&](int row) { return ob + (size_t)row * XW; });
}
}

__device__ __forceinline__ void mix_b_phase(const bf16* PJ, const float* KM, bf16* O, LAS char* vl, int vcu, int wave, int lane) {
    for (int pi = 0; pi < 2; ++pi) { const int p = vcu * 2 + pi, b = p >> 6, h = (p >> 3) & 7, pr = p & 7;
        att::moba_item(PJ, KM, b, h, 15 - pr, wave, O, vl, lane);
        att::moba_item(PJ, KM, b, h, pr, wave, O, vl, lane); }
}
__device__ __forceinline__ void mix_c_phase(const bf16* PJ, bf16* O, bf16* PART, float* LSE, LAS char* vl, int vcu, int wave, int lane) {
    for (int k = 0; k < 24; ++k) { const int idx = (vcu * 24 + k) * 8 + wave, pat = idx >> 14, rem = idx & 16383, b = rem >> 11, h = (rem >> 7) & 15, qt = rem & 127;
        const int dd = (pat == 0) ? 1 : (pat == 1 ? 4 : 16), tpr = 128 / dd  , r = qt / tpr, ut = qt % tpr;
        const float slope2 = ex2(-0.5f * (float)(h + 1)) * LOG2E;
        bf16* out = (pat == 0) ? O + 1024 + h * 64 : PART + (size_t)(pat - 1) * M * 1024 + h * 64;
        att::band_item(PJ, b * SEQ, ut * 32 * dd + r, dd, ut, QC + h * 64, KC + h * 64, VC + h * 64, slope2, 1, 0.f, out, (pat == 0) ? DM : 1024, LSE + (size_t)pat * M * 16 + h, 16, vl, lane); }
}
__device__ __forceinline__ void mix_a_phase(const bf16* PJ, const float* sinks, bf16* O, LAS char* vl, int vcu, int wave, int lane) {
    for (int k = 0; k < 4; ++k) { const int au = vcu * 4 + k, b = au >> 7, kvh = (au >> 6) & 1, chunk = au & 63, h = kvh * 4 + (wave >> 1), qt = chunk * 2 + (wave & 1);
        const float slope2 = ex2(-(float)(h + 1)) * LOG2E;
        att::band_item(PJ, b * SEQ, qt * 32, 1, qt, QA + h * 64, KA + kvh * 64, VA + kvh * 64, slope2, 0, sinks[h] * LOG2E, O + h * 64, DM, nullptr, 0, vl, lane); }
}
__device__ __forceinline__ void mix_x_phase(const bf16* QX, const bf16* KVX, bf16* OX, LAS char* vl, int vcu, int wave, int lane) {
    for (int k = 0; k < 2; ++k) { const int idx = (vcu * 2 + k) * 8 + wave, b = idx >> 9, h = (idx >> 7) & 3, qt = idx & 127;
        att::xattn_item(QX, KVX, b, h, qt, OX, vl, lane); }
}

namespace att2 {
using namespace att;
constexpr int KIMG = 0, VIMG = 49152;
constexpr int MBUF = 65536, MV = 32768;
constexpr int KMS = RING_BYTES + 1024;
#define ATT2_BAR() asm volatile("s_waitcnt lgkmcnt(0)\n\ts_barrier" ::: "memory")

__device__ __forceinline__ int k_lds_off(int row  , int ch) { return row * 128 + ((ch ^ ((row >> 1) & 7)) << 4); }
__device__ __forceinline__ int v_lds_off(int row, int ch8) { return (ch8 >> 2) * 2048 + row * 64 + (ch8 & 3) * 16; }

__device__ __forceinline__ void lds_k(bf16x8 (&kf)[4], LAS const char* ktile, const int (&koff)[4]) {
#pragma unroll
    for (int i = 0; i < 4; ++i) kf[i] = *(const LAS bf16x8*)(ktile + koff[i]); }

__device__ __forceinline__ int imax3(int a, int b, int c) { return max(max(a, b), c); }
template <bool FIRST>
__device__ __forceinline__ void step2(St<4>& s, f32x16& L, const bf16x8 (&qf)[4], LAS const char* ktile, const int (&koff)[4], LAS const char* vimg, float sl, float tb, bool sel, const Mask mk, int r32, int hi) {
    bf16x8 kf[4]; lds_k(kf, ktile, koff);
    s16x4 va[8];
#pragma unroll
    for (int c = 0; c < 2; ++c) { va[4 * c] = vtr(vimg + c * 2048); va[4 * c + 1] = vtr(vimg + c * 2048 + 512); va[4 * c + 2] = vtr(vimg + c * 2048 + 1024); va[4 * c + 3] = vtr(vimg + c * 2048 + 1536); }
    __builtin_amdgcn_sched_barrier(0);
    f32x16 S; { float slo = sl; asm volatile("" : "+v"(slo));
      float base = fmaf(slo, (float)(4 * hi), tb); if (!FIRST) base = sel ? base - s.m : -INFINITY;
#pragma unroll
      for (int r = 0; r < 16; ++r) S[r] = fmaf(slo, (float)crowc(r), base); }
#pragma unroll
    for (int i = 0; i < 4; ++i) S = ATT_MFMA(kf[i], qf[i], S);
    if (mk.on) { const int sv = mk.sgn * (4 * hi - r32);
#pragma unroll
        for (int r = 0; r < 16; ++r) S[r] = (sv >= mk.thr - mk.sgn * crowc(r)) ? S[r] : NEG; }
    if (FIRST) {
        float mx = fmaxf(fmaxf(S[0], S[1]), fmaxf(S[2], S[3]));
#pragma unroll
        for (int r = 4; r < 16; r += 4) mx = fmaxf(mx, fmaxf(fmaxf(S[r], S[r + 1]), fmaxf(S[r + 2], S[r + 3])));
        mx = swapmax(mx);
        if (__any(mx > s.m + THR)) { const float mn = fmaxf(s.m, mx), a = ex2(s.m - mn); L *= a; s.m = mn; s.o[0] *= a; s.o[1] *= a; }
        const float cm = -s.m;
#pragma unroll
        for (int r = 0; r < 16; ++r) S[r] += cm;
    } else {
        int mb = imax3(__float_as_int(S[0]), __float_as_int(S[1]), __float_as_int(S[2]));
#pragma unroll
        for (int r = 3; r < 15; r += 2) mb = imax3(mb, __float_as_int(S[r]), __float_as_int(S[r + 1]));
        mb = max(mb, __float_as_int(S[15]));
        if (__any(__int_as_float(mb) > THR)) {
            float mx = fmaxf(fmaxf(S[0], S[1]), fmaxf(S[2], S[3]));
#pragma unroll
            for (int r = 4; r < 16; r += 4) mx = fmaxf(mx, fmaxf(fmaxf(S[r], S[r + 1]), fmaxf(S[r + 2], S[r + 3])));
            mx = swapmax(mx);
            const float d = fmaxf(mx, 0.f), a = ex2(-d); s.m += d; L *= a; s.o[0] *= a; s.o[1] *= a;
#pragma unroll
            for (int r = 0; r < 16; ++r) S[r] -= d; }
    }
#pragma unroll
    for (int r = 0; r < 16; ++r) S[r] = ex2(S[r]);
    v4u pw0, pw1;
    pw0.x = cvtpk(S[0], S[1]); pw0.y = cvtpk(S[2], S[3]); pw0.z = cvtpk(S[4], S[5]); pw0.w = cvtpk(S[6], S[7]);
    pw1.x = cvtpk(S[8], S[9]); pw1.y = cvtpk(S[10], S[11]); pw1.z = cvtpk(S[12], S[13]); pw1.w = cvtpk(S[14], S[15]);
    const bf16x8 pa0 = __builtin_bit_cast(bf16x8, pw0), pa1 = __builtin_bit_cast(bf16x8, pw1);
    { const v4u o1 = {0x3f803f80u, 0x3f803f80u, 0x3f803f80u, 0x3f803f80u}; const bf16x8 ones = __builtin_bit_cast(bf16x8, o1); L = ATT_MFMA(ones, pa0, L); L = ATT_MFMA(ones, pa1, L); }
#pragma unroll
    for (int c = 0; c < 2; ++c) {
        const bf16x8 v0 = {va[4 * c][0], va[4 * c][1], va[4 * c][2], va[4 * c][3], va[4 * c + 1][0], va[4 * c + 1][1], va[4 * c + 1][2], va[4 * c + 1][3]};
        const bf16x8 v1 = {va[4 * c + 2][0], va[4 * c + 2][1], va[4 * c + 2][2], va[4 * c + 2][3], va[4 * c + 3][0], va[4 * c + 3][1], va[4 * c + 3][2], va[4 * c + 3][3]};
        s.o[c] = ATT_MFMA(v0, pa0, s.o[c]); s.o[c] = ATT_MFMA(v1, pa1, s.o[c]); }
}

struct BandJob { const bf16* row0; int dd, U0, T; int kcol, vcol; };
template <int NP, int VOFF>
__device__ __forceinline__ void band_prefetch(v4u (&kp)[6], v4u (&vp)[6], const BandJob& J, int tid) {
    const bf16* base = J.row0 + J.kcol; const unsigned rp = (unsigned)(J.dd * INW * 2);
#pragma unroll
    for (int j = 0; j < NP; ++j) { int pos = J.U0 - 128 + (tid >> 3) + 64 * j; pos = pos < 0 ? 0 : pos;
        const unsigned off = (unsigned)pos * rp + (unsigned)((tid & 7) * 16);
        asm volatile("global_load_dwordx4 %0, %1, %2" : "=v"(kp[j]) : "v"(off), "s"(base) : "memory");
        asm volatile("global_load_dwordx4 %0, %1, %2 offset:%3" : "=v"(vp[j]) : "v"(off), "s"(base), "n"(VOFF) : "memory"); }
}
template <int NP, int N>
__device__ __forceinline__ void band_wait(v4u (&kp)[6], v4u (&vp)[6]) {
    __builtin_amdgcn_s_waitcnt(0x0F70 | N);
#pragma unroll
    for (int j = 0; j < NP; ++j) asm volatile("" : "+v"(kp[j]), "+v"(vp[j]));
}
template <int NP>
__device__ __forceinline__ void band_write(const v4u (&kp)[6], const v4u (&vp)[6], LAS char* lds, int tid) {
#pragma unroll
    for (int j = 0; j < NP; ++j) { const int row = (tid >> 3) + 64 * j, t = row >> 5, r = row & 31;
        *(LAS v4u*)(lds + KIMG + t * 4096 + k_lds_off(r, tid & 7)) = kp[j];
        *(LAS v4u*)(lds + VIMG + t * 4096 + v_lds_off(r, tid & 7)) = vp[j]; }
}
__device__ __forceinline__ void band_compute(const BandJob& J, int qi, const bf16x8 (&qf)[4], float slope2, int mode, float sink2, bf16* out, int opitch, float* lse, int lpitch, LAS char* lds, LAS char* stg, int lane) {
    const int r32 = lane & 31, hi = lane >> 5, ut = (J.U0 >> 5) + qi;
    const size_t qoff = (size_t)(J.U0 + 32 * qi + r32) * J.dd;
    const float sl = slope2 * (float)J.dd;
    St<4> s; st_init<4>(s, (mode == 0) ? sink2 + sl * (float)r32 : NEG, 0.f);
    f32x16 L;
#pragma unroll
    for (int r = 0; r < 16; ++r) L[r] = (mode == 0) ? 1.f : 0.f;
    int koff[4];
#pragma unroll
    for (int i = 0; i < 4; ++i) koff[i] = k_lds_off(r32, 2 * i + hi);
    const int troff = ((lane >> 4) & 1) * 32 + (lane & 3) * 8 + (4 * hi + ((lane & 15) >> 2)) * 64;
    const int nt = (ut + 1 < 5) ? ut + 1 : 5;
    step2<true>(s, L, qf, lds + KIMG + (qi + 4) * 4096, koff, lds + VIMG + (qi + 4) * 4096 + troff, sl, 0.f, true, mk_diag(), r32, hi);
    for (int k = 1; k < nt; ++k) { const int t = qi + 4 - k;
        step2<false>(s, L, qf, lds + KIMG + t * 4096, koff, lds + VIMG + t * 4096 + troff, sl, -32.f * sl * (float)k, true, (k == 4) ? mk_far(mode) : mk_none(), r32, hi); }
    const float lt = L[0], rl = __builtin_amdgcn_rcpf(lt);
    { const size_t q0r = (size_t)(J.U0 + 32 * qi) * J.dd * opitch, rstep = (size_t)J.dd * opitch;
      st_store_lds<4>(s, rl, stg, lane, [&](int row) { return out + q0r + (size_t)row * rstep; }); }
    if (mode == 1) lse[qoff * lpitch] = s.m + __builtin_amdgcn_logf(lt) - sl * (float)r32;
}

__device__ __forceinline__ void c_decode(const bf16* PJ, int vcu  , int k, BandJob& J, int& pat, int& b, int& h, int& r) { b = vcu >> 5; const int loc = k * 32 + (vcu & 31); h = loc / 48; const int rem = loc - h * 48; pat = rem >> 4; const int qg = rem & 15;
    const int dd = (pat == 0) ? 1 : (pat == 1 ? 4 : 16), tpr = 128 / dd, qt = qg * 8; r = qt / tpr; const int ut0 = qt % tpr;
    J.row0 = PJ + (size_t)(b * SEQ + r) * INW; J.dd = dd; J.U0 = ut0 * 32; J.T = 12; J.kcol = KC + h * 64; J.vcol = VC + h * 64; }
__device__ __forceinline__ void a_decode(const bf16* PJ, int au, BandJob& J, int& b, int& kvh) { b = au >> 7; kvh = (au >> 6) & 1; const int chunk = au & 63;
    J.row0 = PJ + (size_t)(b * SEQ) * INW; J.dd = 1; J.U0 = chunk * 64; J.T = 6; J.kcol = KA + kvh * 64; J.vcol = VA + kvh * 64; }
__device__ __forceinline__ void band_load_q(bf16x8 (&qf)[4], const BandJob& J, int qi, int qcol, int lane) { load_q<4>(qf, J.row0 + (size_t)(J.U0 + 32 * qi + (lane & 31)) * J.dd * INW + qcol + 8 * (lane >> 5)); }
__device__ __forceinline__ void mix_ca_phase(const bf16* PJ, const float* sinks, bf16* O, bf16* PART, float* LSE, LAS char* lds, int vcu, int wave, int lane) {
    const int tid = wave * 64 + lane;
    v4u kp[6], vp[6]; bf16x8 qf[4], qn[4];
    LAS char* stg = lds + 98304 + wave * 4096;
    {   BandJob J; int pat, b, h, r; c_decode(PJ, vcu, 0, J, pat, b, h, r); band_prefetch<6, (VC - KC) * 2>(kp, vp, J, tid); band_load_q(qf, J, wave, QC + h * 64, lane); band_wait<6, 0>(kp, vp);
        for (int k = 0; k < 24; ++k) {
            ATT2_BAR(); band_write<6>(kp, vp, lds, tid); ATT2_BAR();
            BandJob Jn = J; int patn = pat, bn = b, hn = h, rn = r; if (k + 1 < 24) { c_decode(PJ, vcu, k + 1, Jn, patn, bn, hn, rn); band_prefetch<6, (VC - KC) * 2>(kp, vp, Jn, tid); band_load_q(qn, Jn, wave, QC + hn * 64, lane); }
            const float slope2 = ex2(-0.5f * (float)(h + 1)) * LOG2E; const int op = (pat == 0) ? DM : 1024;
            bf16* out = (pat == 0) ? O + (size_t)(b * SEQ + r) * DM + 1024 + h * 64 : PART + ((size_t)(pat - 1) * M + (size_t)(b * SEQ + r)) * 1024 + h * 64;
            band_compute(J, wave, qf, slope2, 1, 0.f, out, op, LSE + ((size_t)pat * M + (size_t)(b * SEQ + r)) * 16 + h, 16, lds, stg, lane);
            band_wait<6, 5>(kp, vp);
            J = Jn; pat = patn; b = bn; h = hn; r = rn;
#pragma unroll
            for (int i = 0; i < 4; ++i) qf[i] = qn[i]; }
    }
    {   BandJob J; int b, kvh; a_decode(PJ, vcu * 4, J, b, kvh); band_prefetch<3, (VA - KA) * 2>(kp, vp, J, tid); band_load_q(qf, J, wave & 1, QA + (kvh * 4 + (wave >> 1)) * 64, lane);
        const float sink2 = sinks[kvh * 4 + (wave >> 1)] * LOG2E;
        band_wait<3, 0>(kp, vp);
        for (int k = 0; k < 4; ++k) {
            ATT2_BAR(); band_write<3>(kp, vp, lds, tid); ATT2_BAR();
            BandJob Jn = J; int bn = b, kvhn = kvh; if (k + 1 < 4) { a_decode(PJ, vcu * 4 + k + 1, Jn, bn, kvhn); band_prefetch<3, (VA - KA) * 2>(kp, vp, Jn, tid); band_load_q(qn, Jn, wave & 1, QA + (kvhn * 4 + (wave >> 1)) * 64, lane); }
            const int h = kvh * 4 + (wave >> 1); const float slope2 = ex2(-(float)(h + 1)) * LOG2E;
            band_compute(J, wave & 1, qf, slope2, 0, sink2, O + (size_t)(b * SEQ) * DM + h * 64, DM, nullptr, 0, lds, stg, lane);
            band_wait<3, 4>(kp, vp);
            J = Jn; b = bn; kvh = kvhn;
#pragma unroll
            for (int i = 0; i < 4; ++i) qf[i] = qn[i]; }
    }
    ATT2_BAR();
}

__device__ __forceinline__ void moba_prefetch(v4u (&kp)[4], v4u (&vp)[4], const bf16* blk0  , int tid) {
#pragma unroll
    for (int j = 0; j < 4; ++j) { const bf16* r = blk0 + (size_t)((tid >> 3) + 64 * j) * INW + (tid & 7) * 8; kp[j] = *(const GAS v4u*)r; vp[j] = *(const GAS v4u*)(r + (VB - KB)); }
}
__device__ __forceinline__ void moba_write(const v4u (&kp)[4], const v4u (&vp)[4], LAS char* buf, int tid) {
#pragma unroll
    for (int j = 0; j < 4; ++j) { const int row = (tid >> 3) + 64 * j, t = row >> 5, r = row & 31;
        *(LAS v4u*)(buf + t * 4096 + k_lds_off(r, tid & 7)) = kp[j];
        *(LAS v4u*)(buf + MV + t * 4096 + v_lds_off(r, tid & 7)) = vp[j]; }
}
__device__ __forceinline__ void moba_wg_item(const bf16* PJ, const float* KM, int b, int h, int blk, bf16* O, LAS char* lds, int wave, int lane) {
    const int tid = wave * 64 + lane, r32 = lane & 31, hi = lane >> 5, w = wave, brow = b * SEQ, q0 = blk * 256 + 32 * w;
    const bf16* kb0 = PJ + (size_t)brow * INW + KB + h * 64;
    v4u kp[4], vp[4];
    moba_prefetch(kp, vp, kb0 + (size_t)(blk * 256) * INW, tid);
    ATT2_BAR();
    if (tid < blk * 16) *(LAS f32x4*)(lds + KMS + tid * 16) = *(const GAS f32x4*)(KM + (size_t)(b * 16 + (tid >> 4)) * 512 + h * 64 + (tid & 15) * 4);
    bf16x8 qf[4]; load_q<4>(qf, PJ + (size_t)(brow + q0 + r32) * INW + QB + h * 64 + 8 * hi);
    const float slope2 = ex2(-(float)(h + 1)) * LOG2E;
    moba_write(kp, vp, lds, tid);
    ATT2_BAR();
    if (blk > 0) moba_prefetch(kp, vp, kb0 + (size_t)((blk - 1) * 256) * INW, tid);
    float g1 = -INFINITY, g2 = -INFINITY, g3 = -INFINITY; int i1 = -1, i2 = -1, i3 = -1;
    for (int n = 0; n < blk; ++n) { const LAS float* km = (const LAS float*)(lds + KMS) + n * 64 + 8 * hi; float g = 0.f;
#pragma unroll
        for (int i = 0; i < 4; ++i) { const f32x4 a = *(const LAS f32x4*)(km + 16 * i), c = *(const LAS f32x4*)(km + 16 * i + 4); const v4u wq = __builtin_bit_cast(v4u, qf[i]);
            g = fmaf(bflo(wq.x), a.x, g); g = fmaf(bfhi(wq.x), a.y, g); g = fmaf(bflo(wq.y), a.z, g); g = fmaf(bfhi(wq.y), a.w, g);
            g = fmaf(bflo(wq.z), c.x, g); g = fmaf(bfhi(wq.z), c.y, g); g = fmaf(bflo(wq.w), c.z, g); g = fmaf(bfhi(wq.w), c.w, g); }
        g = swapsum(g);
        if (g > g1) { g3 = g2; i3 = i2; g2 = g1; i2 = i1; g1 = g; i1 = n; } else if (g > g2) { g3 = g2; i3 = i2; g2 = g; i2 = n; } else if (g > g3) { g3 = g; i3 = n; } }
    unsigned selmask = 0u; if (i1 >= 0) selmask |= 1u << i1; if (i2 >= 0) selmask |= 1u << i2; if (i3 >= 0) selmask |= 1u << i3;
    St<4> s; st_init<4>(s, NEG, 0.f);
    f32x16 L;
#pragma unroll
    for (int r = 0; r < 16; ++r) L[r] = 0.f;
    int koff[4];
#pragma unroll
    for (int i = 0; i < 4; ++i) koff[i] = k_lds_off(r32, 2 * i + hi);
    const int troff = ((lane >> 4) & 1) * 32 + (lane & 3) * 8 + (4 * hi + ((lane & 15) >> 2)) * 64;
    { step2<true>(s, L, qf, lds + w * 4096, koff, lds + MV + w * 4096 + troff, slope2, 0.f, true, mk_diag(), r32, hi);
      for (int k = 1; k <= w; ++k) { const int t = w - k;
        step2<false>(s, L, qf, lds + t * 4096, koff, lds + MV + t * 4096 + troff, slope2, -32.f * slope2 * (float)k, true, mk_none(), r32, hi); } }
    for (int j = 1; j <= blk; ++j) { const int n = blk - j; LAS char* buf = lds + (j & 1) * MBUF;
        moba_write(kp, vp, buf, tid);
        ATT2_BAR();
        if (j < blk) moba_prefetch(kp, vp, kb0 + (size_t)((n - 1) * 256) * INW, tid);
        const bool sel = (selmask >> n) & 1u;
        if (__any(sel)) { const float tb0 = slope2 * (float)((n - blk) * 256 + 224 - 32 * w);
            for (int k = 0; k < 8; ++k) { const int t = 7 - k;
                step2<false>(s, L, qf, buf + t * 4096, koff, buf + MV + t * 4096 + troff, slope2, tb0 - 32.f * slope2 * (float)k, sel, mk_none(), r32, hi); } } }
    const float rl = __builtin_amdgcn_rcpf(L[0]);
    { bf16* ob = O + (size_t)(brow + q0) * DM + 512 + h * 64;
      st_store_lds<4>(s, rl, lds + ((blk + 1) & 1) * MBUF + wave * 4096, lane, [&](int row) { return ob + (size_t)row * DM; }); }
}
__device__ __forceinline__ void mix_b2_phase(const bf16* PJ, const float* KM, bf16* O, LAS char* lds, int vcu, int wave, int lane) {
    for (int pi = 0; pi < 2; ++pi) { const int b = vcu >> 5, tr = vcu & 31, h = pi * 4 + (tr >> 3), pr = tr & 7;
        moba_wg_item(PJ, KM, b, h, 15 - pr, O, lds, wave, lane);
        moba_wg_item(PJ, KM, b, h, pr, O, lds, wave, lane); }
    ATT2_BAR();
}
}

namespace att2 {
__device__ __forceinline__ void xattn_wg(const bf16* QX, const bf16* KVX  , bf16* OX, int pm, int pn, LAS char* lds, int wave, int lane) {
    const int tid = wave * 64 + lane, r32 = lane & 31, hi = lane >> 5, b = pm >> 4;
    const int troff = ((lane >> 4) & 1) * 32 + (lane & 3) * 8 + (4 * hi + ((lane & 15) >> 2)) * 64;
    int koff[8];
#pragma unroll
    for (int i = 0; i < 8; ++i) koff[i] = r32 * 256 + (((2 * i + hi) ^ (r32 & 15)) << 4);
    asm volatile("s_waitcnt vmcnt(0)" ::: "memory");
    for (int hh = 0; hh < 2; ++hh) { const int h = 2 * pn + hh;
        ATT2_BAR();
        { const bf16* src = KVX + (size_t)(b * MEML) * 1024 + h * 128 + (tid & 15) * 8;
#pragma unroll
          for (int j = 0; j < 8; ++j) { const int row = (tid >> 4) + 32 * j, ch = tid & 15; const v4u kk = *(const GAS v4u*)(src + (size_t)row * 1024), vv = *(const GAS v4u*)(src + (size_t)row * 1024 + 512);
              *(LAS v4u*)(lds + j * 8192 + (row & 31) * 256 + ((ch ^ (row & 15)) << 4)) = kk;
              *(LAS v4u*)(lds + 65536 + j * 8192 + (ch >> 2) * 2048 + (row & 31) * 64 + (ch & 3) * 16) = vv; } }
        bf16x8 qf[8]; load_q<8>(qf, QX + (size_t)(pm * 256 + wave * 32 + r32) * XW + h * 128 + 8 * hi);
        ATT2_BAR();
        St<8> s; st_init<8>(s, NEG, 0.f);
        f32x16 zero;
#pragma unroll
        for (int r = 0; r < 16; ++r) zero[r] = 0.f;
        for (int t = 0; t < 8; ++t) { bf16x8 kf[8];
#pragma unroll
            for (int i = 0; i < 8; ++i) kf[i] = *(const LAS bf16x8*)(lds + t * 8192 + koff[i]);
            step<8>(s, qf, kf, lds + 65536 + t * 8192 + troff, zero, 0.f, true, mk_none(), r32, hi); }
        const float rl = __builtin_amdgcn_rcpf(swapsum(s.l));
        ATT2_BAR();
        bf16* ob = OX + (size_t)(pm * 256 + wave * 32) * XW + h * 128;
        st_store_lds<8>(s, rl, lds + wave * 8192, lane, [&](int row) { return ob + (size_t)row * XW; });
    }
    ATT2_BAR();
}
}

#ifndef KM_ATOMIC
#define KM_ATOMIC 1
#endif
#ifndef RESID_ALIGN
#define RESID_ALIGN true
#endif
#ifndef FUSE_X
#define FUSE_X 1
#endif
#ifndef ATT_V2
#define ATT_V2 1
#endif
#ifndef MFMA_A
#define MFMA_A 1
#endif
#ifndef MFMA_B
#define MFMA_B 1
#endif
#ifndef MFMA_C
#define MFMA_C 1
#endif
#ifndef MFMA_X
#define MFMA_X 1
#endif
constexpr int PH_L0 = 2, PH_PER_LAYER = 9, PH_FINAL = PH_L0 + DEPTH * PH_PER_LAYER, PH_END = PH_FINAL + 1;
struct Args { Ptrs p; float* out; unsigned char* ws; int ph_lo, ph_hi, mixmask, pad; };
static_assert(sizeof(Args) == 22 * 8 + 16, "Args has no padding bytes");
__global__ void __launch_bounds__(NWAVES * 64, 2) trunk_fwd(Args args) {
    extern __shared__ __attribute__((aligned(16))) unsigned char lds_raw[];
    LAS unsigned char* lds = (LAS unsigned char*)lds_raw;
    volatile LAS unsigned* MISC = (volatile LAS unsigned*)(lds + MISC_OFF);
    const int tid = threadIdx.x, lane0 = tid & 63, wave = __builtin_amdgcn_readfirstlane(tid >> 6);
    const int G = gridDim.x; const int bx = blockIdx.x; const int vcu = (G % 8 == 0) ? (bx % 8) * (G / 8) + bx / 8 : bx;
    const int gw = vcu * NWAVES + wave, NGW = G * NWAVES, gtid0 = gw * 64 + lane0, nthr = NGW * 64;
    unsigned char* ws = args.ws; const Ptrs& P = args.p;
    gu32* ctl = (gu32*)(ws + WS_CTL);
    for (int u = tid; u < (LDS_BYTES - LDSCTL_OFF) / 4; u += NWAVES * 64) ((LAS unsigned*)(lds + LDSCTL_OFF))[u] = 0u;
    __syncthreads();
    XcdBarrier bar; bar.bar = (unsigned*)(ctl + CW_BAR); bar.x = xb_xcc_id(); bar.st = MISC + 8;
    if (tid == 0) MISC[10] = xcd_barrier_post_rank(bar.bar, bar.x);
    __syncthreads();
    const int xrank = __builtin_amdgcn_readfirstlane((int)MISC[10]);
    const int lo = args.ph_lo, hi = args.ph_hi;
#define IN(k) (lo <= (k) && (k) < hi)
#define SEAM(k) do { if (IN(k) && IN((k) + 1)) xcd_barrier2(bar, false); } while (0)
#define TSEAM(k) do { if (IN(k) && IN((k) + 1)) xcd_barrier2(bar, teams); } while (0)
    bf16* XN = (bf16*)(ws + WS_XN); bf16* BIG = (bf16*)(ws + WS_BIG); bf16* QX = (bf16*)(ws + WS_QX); bf16* OX = (bf16*)(ws + WS_OX);
    bf16* H16 = (bf16*)args.out;

    if (IN(0)) { p0_convert(P, ws, H16, (LAS char*)(lds + RING_OFF + wave * 16384), gw, NGW, lane0); }
    SEAM(0);
    bool teams = false;
    if (lo == 0 && hi == PH_END && G == 256) { if (tid == 0) { unsigned ok = 1u;
#pragma unroll
            for (unsigned j = 0; j < 16; ++j) { const unsigned c = xb_ld(&bar.bar[XB_XCNT(j)]); ok &= (j < 8u) ? (c == 32u) : (c == 0u); }
            MISC[11] = ok; }
        __syncthreads(); teams = __builtin_amdgcn_readfirstlane((int)MISC[11]) != 0; }
    const int vcu2 = teams ? (int)bar.x * 32 + xrank : vcu;
    for (int l = 0; l < DEPTH; ++l) {
        unsigned zl = 0u; asm volatile("" : "+s"(zl));
        int lane = (int)__builtin_amdgcn_mbcnt_hi(~0u, __builtin_amdgcn_mbcnt_lo(~0u, zl)), wave_l = wave, vcu_l = vcu2; asm volatile("" : "+v"(lane), "+s"(wave_l), "+s"(vcu_l));
        const int gtid = gw * 64 + lane; (void)gtid;
#define TEAMVARS int team = vcu_l >> 5, trank = vcu_l & 31; asm volatile("" : "+s"(team), "+s"(trank)); bf16* PJt = BIG + (size_t)team * (1u << 20); bf16* QXt = XN + (size_t)team * (6u << 20); bf16* OXt = XN + (2u << 20) + (size_t)team * (6u << 20); (void)PJt; (void)QXt; (void)OXt
        const int pb = PH_L0 + l * PH_PER_LAYER;
        unsigned char* wl = ws + WS_WL + (size_t)l * WL_STRIDE;
        float* KM = (float*)(ws + WS_KMEAN) + (size_t)l * (M / 256) * 512;
        unsigned long long* SS = (unsigned long long*)(ws + WS_SS) + (size_t)(3 * l) * M;
        bf16* PARTB = (bf16*)(ws + WS_PART);
#ifdef PROBE_DRY
        const bool dry = (args.mixmask & 8) != 0;
#else
        constexpr bool dry = false;
#endif
        bf16* RO = dry ? PARTB : H16; unsigned long long* SSD = (unsigned long long*)(ws + WS_SS) + (size_t)13 * M;
        if (IN(pb + 0)) { TEAMVARS; pg8::Gemm g{H16, (const bf16*)(wl + WL_IN), M, INW, DM}; pg8::TeamOrder S{INW / 256, team, trank};
            pg8::EpiBf16S E{PJt, INW, C2, (1u << 0) | (1u << 1) | (1u << 3) | (1u << 4) | (1u << 9) | (1u << 10) | (1u << 11) | (1u << 12), 0xff, SS, KM_ATOMIC ? KM : nullptr, (pg8::lds_f32*)(lds + RING_BYTES + 10240), (l * 4 + 1) << 9};
            pg8::gemm_phase<pg8::EpiBf16S, pg8::TeamOrder, true, true>(lds + RING_OFF, g, S, E, wave_l);
            if (trank >= 28) {
                const int ku = team * 4 + (trank - 28);
                pg8::Gemm gk{(const bf16*)(ws + WS_MEMN) + (size_t)l * MROWS * DM, (const bf16*)(ws + WS_WKV) + (size_t)l * 1024 * DM, MROWS, 1024, DM}; pg8::OneUnit SK{ku >> 2, ku & 3};
                pg8::EpiBf16S EK{(bf16*)(ws + WS_KVX) + (size_t)l * MROWS * 1024, 1024, 1.f, 0u, 0xff, nullptr, nullptr, (pg8::lds_f32*)(lds + RING_BYTES + 10240), 0};
                pg8::gemm_phase<pg8::EpiBf16S, pg8::OneUnit, true, true>(lds + RING_OFF, gk, SK, EK, wave_l); } }
        TSEAM(pb + 0);
#if !KM_ATOMIC
        if (IN(pb + 0)) { kmean_phase(BIG, KM, gw, NGW, lane); xcd_barrier2(bar, false); }
#endif
        if (IN(pb + 1)) { TEAMVARS;
#if ATT_V2
            if (args.mixmask & 1) att2::mix_b2_phase(PJt, KM, XN, (LAS char*)lds, vcu_l, wave_l, lane);
            if (args.mixmask & 6) att2::mix_ca_phase(PJt, P.sinks + l * 8, XN, PARTB, (float*)(ws + WS_LSE), (LAS char*)lds, vcu_l, wave_l, lane);
#else
            LAS char* vl = (LAS char*)(lds + RING_OFF + wave_l * 16384);
            if (args.mixmask & 1) mix_b_phase(BIG, KM, XN, vl, vcu_l, wave_l, lane);
            if (args.mixmask & 2) mix_c_phase(BIG, XN, PARTB, (float*)(ws + WS_LSE), vl, vcu_l, wave_l, lane);
            if (args.mixmask & 4) mix_a_phase(BIG, P.sinks + l * 8, XN, vl, vcu_l, wave_l, lane);
#endif
        }
        TSEAM(pb + 1);
        if (IN(pb + 2)) { TEAMVARS; ynorm_phase<MFMA_C != 0>(XN, dry ? BIG : XN, PARTB, (const float*)(ws + WS_LSE), P.gain_a + l * 512, P.gain_b + l * 512, P.gain_c + l * 1024, team * SEQ + trank * NWAVES + wave_l, (team + 1) * SEQ, 32 * NWAVES, lane); }
        TSEAM(pb + 2);
        if (IN(pb + 3)) { TEAMVARS; pg8::Gemm g{XN, (const bf16*)(wl + WL_OUT), M, DM, DM}; pg8::TeamOrder S{DM / 256, team, trank};
            pg8::EpiResid E{H16, RO, DM, dry ? SSD : SS + M, (LAS unsigned long long*)(lds + RING_BYTES + 8192)};
            pg8::gemm_phase<pg8::EpiResid, pg8::TeamOrder, RESID_ALIGN, true>(lds + RING_OFF, g, S, E, wave_l); }
        TSEAM(pb + 3);
        if (IN(pb + 4)) { TEAMVARS; pg8::Gemm g{H16, (const bf16*)(wl + WL_Q), M, XW, DM}; pg8::TeamOrder S{XW / 256, team, trank};
            pg8::EpiBf16S E{QXt, XW, CX2, 3u, 0xff, SS + M, nullptr, (pg8::lds_f32*)(lds + RING_BYTES + 10240), (l * 4 + 2) << 9};
            pg8::gemm_phase<pg8::EpiBf16S, pg8::TeamOrder, true, true>(lds + RING_OFF, g, S, E, wave_l);
#if FUSE_X
            pg8::Unit u; for (int i = 0; S.next(i, u); ++i) att2::xattn_wg(QXt, (const bf16*)(ws + WS_KVX) + (size_t)l * MROWS * 1024, OXt, u.pm, u.pn, (LAS char*)lds, wave_l, lane);
#endif
        }
        TSEAM(pb + 4);
#if !FUSE_X
#if MFMA_X
        if (IN(pb + 5)) mix_x_phase(QX, (const bf16*)(ws + WS_KVX) + (size_t)l * MROWS * 1024, OX, (LAS char*)(lds + RING_OFF + wave_l * 16384), vcu_l, wave_l, lane);
#else
        if (IN(pb + 5)) naive_attn_x(QX, (const bf16*)(ws + WS_KVX) + (size_t)l * MROWS * 1024, OX, gtid, nthr);
#endif
        TSEAM(pb + 5);
#endif
        if (IN(pb + 6)) { TEAMVARS; pg8::Gemm g{OXt, (const bf16*)(wl + WL_O), M, DM, XW}; pg8::TeamOrder S{DM / 256, team, trank};
            pg8::EpiResid E{H16, RO, DM, dry ? SSD : SS + 2 * M, (LAS unsigned long long*)(lds + RING_BYTES + 8192)};
            pg8::gemm_phase<pg8::EpiResid, pg8::TeamOrder, RESID_ALIGN, true>(lds + RING_OFF, g, S, E, wave_l); }
        TSEAM(pb + 6);
        if (IN(pb + 7)) { TEAMVARS; pg8::Gemm g{H16, (const bf16*)(wl + WL_GU), M, NGU, DM}; pg8::TeamOrder S{NGU / 256, team, trank};
            pg8::EpiSwiGLU E{BIG, DFF, SS + 2 * M, (args.mixmask & 32) ? 2 : ((args.mixmask & 16) ? 1 : 0), (pg8::lds_f32*)(lds + RING_BYTES + 10240), (l * 4 + 3) << 9};
            pg8::gemm_phase<pg8::EpiSwiGLU, pg8::TeamOrder, true, true>(lds + RING_OFF, g, S, E, wave_l); }
        TSEAM(pb + 7);
        if (IN(pb + 8)) { TEAMVARS; pg8::Gemm g{BIG, (const bf16*)(wl + WL_DN), M, DM, DFF}; pg8::TeamOrder S{DM / 256, team, trank};
            pg8::EpiResid E{H16, dry ? PARTB : ((l == DEPTH - 1) ? XN : H16), DM, dry ? SSD : SS + 3 * M, (LAS unsigned long long*)(lds + RING_BYTES + 8192)};
            pg8::gemm_phase<pg8::EpiResid, pg8::TeamOrder, RESID_ALIGN, true>(lds + RING_OFF, g, S, E, wave_l); }
        if (l == DEPTH - 1) SEAM(pb + 8); else TSEAM(pb + 8);
    }
    if (IN(PH_FINAL)) {
        unsigned zl = 0u; asm volatile("" : "+s"(zl));
        int lane = (int)__builtin_amdgcn_mbcnt_hi(~0u, __builtin_amdgcn_mbcnt_lo(~0u, zl)), gwf = gw; asm volatile("" : "+v"(lane), "+s"(gwf));
        f32x4 g[4][2];
#pragma unroll
        for (int j = 0; j < 4; ++j) { g[j][0] = *(const GAS f32x4*)(P.norm_final + 512 * j + 8 * lane); g[j][1] = *(const GAS f32x4*)(P.norm_final + 512 * j + 8 * lane + 4); }
        int team = vcu2 >> 5, trank = vcu2 & 31; asm volatile("" : "+s"(team), "+s"(trank)); (void)gwf;
        for (int m0 = team * SEQ + trank * NWAVES + wave; m0 < (team + 1) * SEQ; m0 += 2 * 32 * NWAVES) { v4u w4[2][4];
#pragma unroll
            for (int q = 0; q < 2; ++q) { const GAS v4u* row = (const GAS v4u*)(XN + (size_t)(m0 + q * 32 * NWAVES) * DM) + lane;
#pragma unroll
                for (int j = 0; j < 4; ++j) w4[q][j] = row[64 * j]; }
#pragma unroll
            for (int q = 0; q < 2; ++q) { const int m = m0 + q * 32 * NWAVES; float v[4][8]; float s = 0.f;
#pragma unroll
                for (int j = 0; j < 4; ++j) { const v4u w = w4[q][j]; v[j][0] = bflo(w.x); v[j][1] = bfhi(w.x); v[j][2] = bflo(w.y); v[j][3] = bfhi(w.y); v[j][4] = bflo(w.z); v[j][5] = bfhi(w.z); v[j][6] = bflo(w.w); v[j][7] = bfhi(w.w);
#pragma unroll
                    for (int e2 = 0; e2 < 8; ++e2) s += v[j][e2] * v[j][e2]; }
                const float rstd = 1.f / sqrtf(wave_sum(s) * (1.f / DM) + EPS);
                GAS f32x4* o = (GAS f32x4*)(args.out + (size_t)m * DM + 8 * lane);
#pragma unroll
                for (int j = 0; j < 4; ++j) { o[128 * j] = (f32x4){v[j][0] * rstd * g[j][0].x, v[j][1] * rstd * g[j][0].y, v[j][2] * rstd * g[j][0].z, v[j][3] * rstd * g[j][0].w};
                    o[128 * j + 1] = (f32x4){v[j][4] * rstd * g[j][1].x, v[j][5] * rstd * g[j][1].y, v[j][6] * rstd * g[j][1].z, v[j][7] * rstd * g[j][1].w}; } } }
    }
#undef IN
#undef SEAM
#undef TSEAM
}

#ifndef MK_MODE
#define MK_MODE 1
#endif
extern "C" void kernel_launch(void* const* d_in, const int* in_sizes, int n_in, void* d_out, int out_size, void* d_ws, size_t ws_size, hipStream_t stream) {
    static int grid = 0;
    if (grid == 0) {
        if (n_in != 20 || in_sizes[0] != M * DM || out_size != M * DM || ws_size < WS_END) { fprintf(stderr, "kernel_launch: unexpected shapes / workspace (%zu < %zu)\n", ws_size, (size_t)WS_END); grid = -1; return; }
        int dev = 0, cus = 0, per_cu = 0;
        if (hipGetDevice(&dev) != hipSuccess || hipDeviceGetAttribute(&cus, hipDeviceAttributeMultiprocessorCount, dev) != hipSuccess) { grid = -1; return; }
        if (hipFuncSetAttribute((const void*)trunk_fwd, hipFuncAttributeMaxDynamicSharedMemorySize, LDS_BYTES) != hipSuccess) { grid = -1; return; }
        if (hipOccupancyMaxActiveBlocksPerMultiprocessor(&per_cu, (const void*)trunk_fwd, NWAVES * 64, LDS_BYTES) != hipSuccess || per_cu < 1) { fprintf(stderr, "kernel_launch: occupancy query reports %d\n", per_cu); }
        (void)hipGetLastError();
        grid = cus;
        if (grid != 256) { fprintf(stderr, "kernel_launch: the static work deal of this kernel is built for 256 CUs (MI355X); found %d: nothing launched\n", cus); grid = -1; return; }
    }
    if (grid < 0) return;
    if (hipMemsetAsync((char*)d_ws + WS_CTL, 0, CTL_ZERO_BYTES, stream) != hipSuccess) return;
    if (hipMemsetAsync((char*)d_ws + WS_SS, 0, SS_BYTES, stream) != hipSuccess) return;
    Args a{};
    const float** pp = (const float**)&a.p;
    for (int i = 0; i < 20; ++i) pp[i] = (const float*)d_in[i];
    a.out = (float*)d_out; a.ws = (unsigned char*)d_ws; a.mixmask = 7;
#if MK_MODE == 1
    a.ph_lo = 0; a.ph_hi = PH_END;
    hipLaunchKernelGGL(trunk_fwd, dim3(grid), dim3(NWAVES * 64), LDS_BYTES, stream, a);
#else
    for (int k = 0; k < PH_END; ++k) {
        a.ph_lo = k; a.ph_hi = k + 1; a.mixmask = 7;
#ifdef PROBE_DRY
        if (k >= PH_L0 && k < PH_FINAL && (k - PH_L0) % PH_PER_LAYER == PROBE_DRY) { a.mixmask = 15; hipLaunchKernelGGL(trunk_fwd, dim3(grid), dim3(NWAVES * 64), LDS_BYTES, stream, a); a.mixmask = 7; }
#endif
        hipLaunchKernelGGL(trunk_fwd, dim3(grid), dim3(NWAVES * 64), LDS_BYTES, stream, a);
#ifdef PROBE_PH
        if ((PROBE_PH >= 0 && k >= PH_L0 && k < PH_FINAL && (k - PH_L0) % PH_PER_LAYER == PROBE_PH) || (PROBE_PH == -1 && k == 0) || (PROBE_PH == -2 && k == 1)) {
            a.mixmask = PROBE_MIX; hipLaunchKernelGGL(trunk_fwd, dim3(grid), dim3(NWAVES * 64), LDS_BYTES, stream, a); }
#endif
    }
#endif
}
```

```cpp
#include <hip/hip_runtime.h>
#include <cstdio>
#include <cstdint>
template <int CTRL> __device__ __forceinline__ float lane_dpp(float v) { return __builtin_bit_cast(float, __builtin_amdgcn_update_dpp(0, __builtin_bit_cast(int, v), CTRL, 0xf, 0xf, true)); }
__device__ __forceinline__ float sum_row16(float v) {
    v += lane_dpp<0xB1>(v); v += lane_dpp<0x4E>(v); v += lane_dpp<0x141>(v); v += lane_dpp<0x140>(v); return v; }
__device__ __forceinline__ float sum_x16(float v) { return v + __builtin_bit_cast(float, __builtin_amdgcn_ds_swizzle(__builtin_bit_cast(int, v), 0x401f)); }
__device__ __forceinline__ void swap32(float v, float& a, float& b) { float x = v, y = v; asm volatile("s_nop 1\n\tv_permlane32_swap_b32 %0, %1" : "+v"(x), "+v"(y)); a = x; b = y; }
__device__ __forceinline__ float sum_x32(float v) { float a, b; swap32(v, a, b); return a + b; }
namespace pg8 {
#define PG8_LAS __attribute__((address_space(3)))
typedef unsigned short bf16_t;
typedef short bf16x8 __attribute__((ext_vector_type(8)));
typedef float f32x4 __attribute__((ext_vector_type(4)));
typedef unsigned u32x4 __attribute__((ext_vector_type(4)));
constexpr int BM = 256, BK = 64, HALF = 128, HTB = HALF * BK * 2  , STAGE_BYTES = 8 * HTB, NXCD = 8, WGM = 8;

__host__ __device__ __forceinline__ int lds_byte(int r, int c) { const int st = (r >> 4) * 2 + (c >> 5), rr = r & 15, cc = c & 31, ob = rr * 64 + cc * 2; return st * 1024 + (ob ^ (((ob >> 9) & 1) << 5)); }
__host__ __device__ __forceinline__ void stage_rc(int b, int& R, int& C) { const int st = b / 1024, sb = b % 1024, swz = sb ^ (((sb >> 9) & 1) << 5); R = (st >> 1) * 16 + swz / 64; C = (st & 1) * 32 + (swz % 64) / 2; }
__host__ __device__ __forceinline__ int perm32(int rho) { const int n = rho >> 4, i = rho & 15; return 8 * (i >> 2) + 4 * n + (i & 3); }

struct Unit { int pm, pn; };
struct Gemm { const bf16_t* A; const bf16_t* Bt; int M, N, K; };

struct StaticOrder {
    int nM, nN, nwg, G, c;
    __host__ __device__ void init(int M, int N, int G_, int c_) { nM = M / BM; nN = N / BM; nwg = nM * nN; G = G_; c = c_; }
    __host__ __device__ bool next(int i, Unit& u) const {
        const long L = (long)i * G + c; if (L >= nwg) return false;
        int wgid = (int)L; { const int q = nwg / NXCD, r = nwg % NXCD, xcd = wgid % NXCD, off = wgid / NXCD; wgid = (xcd < r ? xcd * (q + 1) : r * (q + 1) + (xcd - r) * q) + off; }
        const int nig = WGM * nN, gid = wgid / nig, fm = gid * WGM, gsz = (nM - fm) < WGM ? (nM - fm) : WGM;
        u.pm = fm + ((wgid % nig) % gsz); u.pn = (wgid % nig) / gsz; return true;
    }
    __device__ __forceinline__ void a_ready(const Unit&) const {}
    __device__ __forceinline__ void done(const Unit&) const {}
};


typedef unsigned wt_v4u __attribute__((ext_vector_type(4)));
__device__ __forceinline__ __amdgpu_buffer_rsrc_t wt_rsrc(const void* base) { return __builtin_amdgcn_make_buffer_rsrc((void*)base, (short)0, 0x7ffffff0, 0x00020000); }
__device__ __forceinline__ void wt_store16(__amdgpu_buffer_rsrc_t rs, size_t byteoff, u32x4 v) { __builtin_amdgcn_raw_buffer_store_b128(__builtin_bit_cast(wt_v4u, v), rs, (int)(unsigned)byteoff, 0, 16); }
typedef float cv_f32x2 __attribute__((ext_vector_type(2)));
typedef __bf16 cv_bf16x2 __attribute__((ext_vector_type(2)));
__device__ __forceinline__ unsigned cvt_pk_bf16(float lo, float hi) { cv_f32x2 v = {lo, hi}; return __builtin_bit_cast(unsigned, __builtin_convertvector(v, cv_bf16x2)); }

#ifndef SS_ATOMIC
#define SS_ATOMIC 1
#endif
__device__ __forceinline__ float rstd_of(unsigned long long q) { const float s = (float)(unsigned)(q >> 32) + (float)(unsigned)q * (1.f / 4294967296.f); return __builtin_amdgcn_rsqf(s * (1.f / 2048.f) + 1e-5f); }
typedef __attribute__((address_space(3))) float lds_f32;
typedef __attribute__((address_space(3))) int lds_i32;
__device__ __forceinline__ void rstd_rows(float (&rs)[2][4], const unsigned long long* ss, int row0, int tag, lds_f32* stash  , int wid, int fr, int fq) {
    lds_f32* mine = stash + wid * 128; lds_i32* tagw = (lds_i32*)(stash + 8 * 128) + wid;
    const int have = __builtin_amdgcn_readfirstlane(*tagw);
    if (have == tag) {
#pragma unroll
        for (int ai = 0; ai < 2; ++ai)
#pragma unroll
            for (int m = 0; m < 4; ++m) rs[ai][m] = mine[ai * 64 + m * 16 + fr];
    } else {
        unsigned long long sv[2][4];
#pragma unroll
        for (int ai = 0; ai < 2; ++ai)
#pragma unroll
            for (int m = 0; m < 4; ++m) sv[ai][m] = ss[row0 + ai * HALF + m * 16];
#pragma unroll
        for (int ai = 0; ai < 2; ++ai)
#pragma unroll
            for (int m = 0; m < 4; ++m) { rs[ai][m] = rstd_of(sv[ai][m]); if (fq == 0) mine[ai * 64 + m * 16 + fr] = rs[ai][m]; }
        *tagw = tag;
    }
}
struct EpiBf16S {
    static constexpr bool PERM = true, AFTER_DRAIN = false;
    bf16_t* O; int ldc; float scale; unsigned smask; int pn_and; const unsigned long long* ss; float* km; lds_f32* stash; int tag0;
    __device__ __forceinline__ void operator()(const f32x4 (&acc)[2][2][4][2], const Unit& u, int wr, int wc, int fr, int fq) const {
        const int row0 = u.pm * BM + wr * 64 + fr; const int pn = u.pn & pn_and; const int col0 = pn * BM + wc * 32 + 8 * fq;
        const float sc = ((smask >> pn) & 1u) ? scale : 1.f;
        const bool dokm = (km != nullptr) && (pn == 5 || pn == 6);
        f32x4 cs[2][2];
#pragma unroll
        for (int bj = 0; bj < 2; ++bj) { cs[bj][0] = (f32x4){0.f, 0.f, 0.f, 0.f}; cs[bj][1] = (f32x4){0.f, 0.f, 0.f, 0.f}; }
        float rsv[2][4];
        if (ss) rstd_rows(rsv, ss, row0, tag0 + u.pm + 1, stash, wr * 4 + wc, fr, fq);
#pragma unroll
        for (int ai = 0; ai < 2; ++ai)
#pragma unroll
            for (int m = 0; m < 4; ++m) { const int row = row0 + ai * HALF + m * 16; const size_t ro = ((size_t)row * ldc + col0) * 2;
                float rs = sc; if (ss) rs *= rsv[ai][m];
#pragma unroll
                for (int bj = 0; bj < 2; ++bj) { f32x4 v0 = acc[ai][bj][m][0] * rs, v1 = acc[ai][bj][m][1] * rs;
                    cs[bj][0] += v0; cs[bj][1] += v1;
                    u32x4 w; w.x = cvt_pk_bf16(v0[0], v0[1]); w.y = cvt_pk_bf16(v0[2], v0[3]); w.z = cvt_pk_bf16(v1[0], v1[1]); w.w = cvt_pk_bf16(v1[2], v1[3]);
                    *(u32x4*)(O + (ro >> 1) + bj * HALF) = w; } }
        if (dokm) { float mine = 0.f;
#pragma unroll
            for (int bj = 0; bj < 2; ++bj)
#pragma unroll
                for (int n = 0; n < 2; ++n)
#pragma unroll
                    for (int i = 0; i < 4; ++i) { const float v = sum_row16(cs[bj][n][i]); mine = (fr == bj * 8 + n * 4 + i) ? v : mine; }
            unsafeAtomicAdd(km + (size_t)u.pm * 512 + (col0 - 1280) + (fr >> 3) * HALF + (fr & 7), mine); }
    }
};
struct EpiResid {
    static constexpr bool PERM = true, AFTER_DRAIN = false;
    const bf16_t* in; bf16_t* out; int ldc; unsigned long long* ss_out; __attribute__((address_space(3))) unsigned long long* lss;
    __device__ __forceinline__ void operator()(const f32x4 (&acc)[2][2][4][2], const Unit& u, int wr, int wc, int fr, int fq) const {
        const int row0 = u.pm * BM + wr * 64 + fr, col0 = u.pn * BM + wc * 32 + 8 * fq;
        u32x4 rin[2][4][2];
#pragma unroll
        for (int ai = 0; ai < 2; ++ai)
#pragma unroll
            for (int m = 0; m < 4; ++m)
#pragma unroll
                for (int bj = 0; bj < 2; ++bj) rin[ai][m][bj] = *(const u32x4*)(in + (size_t)(row0 + ai * HALF + m * 16) * ldc + col0 + bj * HALF);
#pragma unroll
        for (int ai = 0; ai < 2; ++ai)
#pragma unroll
            for (int m = 0; m < 4; ++m) { const int row = row0 + ai * HALF + m * 16; const size_t off = (size_t)row * ldc + col0;
                typedef float f32x2 __attribute__((ext_vector_type(2)));
                f32x2 sq2 = {0.f, 0.f}, sq3 = {0.f, 0.f};
#pragma unroll
                for (int bj = 0; bj < 2; ++bj) { const u32x4 w0 = rin[ai][m][bj];
                    const f32x4 a0 = acc[ai][bj][m][0], a1 = acc[ai][bj][m][1];
                    f32x2 p0 = (f32x2){a0[0], a0[1]} + (f32x2){__builtin_bit_cast(float, w0.x << 16), __builtin_bit_cast(float, w0.x & 0xffff0000u)};
                    f32x2 p1 = (f32x2){a0[2], a0[3]} + (f32x2){__builtin_bit_cast(float, w0.y << 16), __builtin_bit_cast(float, w0.y & 0xffff0000u)};
                    f32x2 p2 = (f32x2){a1[0], a1[1]} + (f32x2){__builtin_bit_cast(float, w0.z << 16), __builtin_bit_cast(float, w0.z & 0xffff0000u)};
                    f32x2 p3 = (f32x2){a1[2], a1[3]} + (f32x2){__builtin_bit_cast(float, w0.w << 16), __builtin_bit_cast(float, w0.w & 0xffff0000u)};
                    sq2 = __builtin_elementwise_fma(p0, p0, sq2); sq3 = __builtin_elementwise_fma(p1, p1, sq3); sq2 = __builtin_elementwise_fma(p2, p2, sq2); sq3 = __builtin_elementwise_fma(p3, p3, sq3);
                    u32x4 w; w.x = cvt_pk_bf16(p0.x, p0.y); w.y = cvt_pk_bf16(p1.x, p1.y); w.z = cvt_pk_bf16(p2.x, p2.y); w.w = cvt_pk_bf16(p3.x, p3.y);
                    *(u32x4*)(out + off + bj * HALF) = w; }
                float sq = (sq2.x + sq2.y) + (sq3.x + sq3.y);
                sq = sum_x32(sum_x16(sq));
                if (SS_ATOMIC && fq == 0) { const unsigned hi_ = (unsigned)sq, lo_ = (unsigned)((sq - (float)hi_) * 4294967296.f);
                    __hip_atomic_fetch_add(lss + (wr * 128 + ai * 64 + m * 16 + fr), ((unsigned long long)hi_ << 32) | lo_, __ATOMIC_RELAXED, __HIP_MEMORY_SCOPE_WORKGROUP); } }
        if (SS_ATOMIC) {
            asm volatile("s_waitcnt lgkmcnt(0)\n\ts_barrier" ::: "memory");
            const int ln = fq * 16 + fr;
            if (ln < 32) { const int d = wr * 128 + wc * 32 + ln; const unsigned long long v = lss[d]; lss[d] = 0ull;
                atomicAdd(ss_out + (u.pm * BM + ((d >> 6) & 1) * HALF + wr * 64 + ((d >> 4) & 3) * 16 + (d & 15)), v); } }
    }
};
struct EpiSwiGLU {
    static constexpr bool PERM = true, AFTER_DRAIN = false;
    bf16_t* O; int ldc; const unsigned long long* ss; int nostore; lds_f32* stash; int tag0;
    __device__ __forceinline__ void operator()(const f32x4 (&acc)[2][2][4][2], const Unit& u, int wr, int wc, int fr, int fq) const {
        if (nostore == 2) return;
        const int row0 = u.pm * BM + wr * 64 + fr, col0 = u.pn * HALF + wc * 32 + 8 * fq;
        float rsv[2][4];
        rstd_rows(rsv, ss, row0, tag0 + u.pm + 1, stash, wr * 4 + wc, fr, fq);
#pragma unroll
        for (int ai = 0; ai < 2; ++ai)
#pragma unroll
            for (int m = 0; m < 4; ++m) { const int row = row0 + ai * HALF + m * 16; const size_t ro = ((size_t)row * ldc + col0) * 2;
                typedef float f32x2 __attribute__((ext_vector_type(2)));
                const float rs = rsv[ai][m], c1 = -1.4426950408889634f * rs, rs2 = rs * rs;
                f32x2 G[4], U[4], T[4];
#pragma unroll
                for (int i = 0; i < 4; ++i) { G[i] = (f32x2){acc[ai][0][m][i >> 1][2 * (i & 1)], acc[ai][0][m][i >> 1][2 * (i & 1) + 1]}; U[i] = (f32x2){acc[ai][1][m][i >> 1][2 * (i & 1)], acc[ai][1][m][i >> 1][2 * (i & 1) + 1]}; }
#pragma unroll
                for (int i = 0; i < 4; ++i) T[i] = G[i] * c1;
#pragma unroll
                for (int i = 0; i < 4; ++i) T[i] = (f32x2){__builtin_amdgcn_exp2f(T[i].x), __builtin_amdgcn_exp2f(T[i].y)};
#pragma unroll
                for (int i = 0; i < 4; ++i) T[i] = T[i] + 1.f;
#pragma unroll
                for (int i = 0; i < 4; ++i) T[i] = (f32x2){__builtin_amdgcn_rcpf(T[i].x), __builtin_amdgcn_rcpf(T[i].y)};
#pragma unroll
                for (int i = 0; i < 4; ++i) T[i] = ((G[i] * U[i]) * T[i]) * rs2;
                u32x4 w; w.x = cvt_pk_bf16(T[0].x, T[0].y); w.y = cvt_pk_bf16(T[1].x, T[1].y); w.z = cvt_pk_bf16(T[2].x, T[2].y); w.w = cvt_pk_bf16(T[3].x, T[3].y);
                if (!nostore) *(u32x4*)(O + (ro >> 1)) = w; }
    }
};
struct TeamOrder {
    int nN, t, r;
    __device__ __forceinline__ bool next(int i, Unit& u) const { const int li = i * 32 + r; if (li >= 16 * nN) return false; const int gid = li / (8 * nN), idx = li % (8 * nN);
        u.pm = 16 * t + 8 * gid + (idx & 7); u.pn = idx >> 3; return true; }
    __device__ __forceinline__ void a_ready(const Unit&) const {}
    __device__ __forceinline__ void done(const Unit&) const {}
};
struct OneUnit {
    int pm, pn;
    __device__ __forceinline__ bool next(int i, Unit& u) const { if (i != 0) return false; u.pm = pm; u.pn = pn; return true; }
    __device__ __forceinline__ void a_ready(const Unit&) const {}
    __device__ __forceinline__ void done(const Unit&) const {}
};
struct KvOrder {
    int G, c;
    __device__ __forceinline__ bool next(int i, Unit& u) const { const int L = i * G + c; if (L >= 128) return false; u.pm = L >> 2; u.pn = ((L >> 5) << 2) + (L & 3); return true; }
    __device__ __forceinline__ void a_ready(const Unit&) const {}
    __device__ __forceinline__ void done(const Unit&) const {}
};
template <class Epi, class Sched, bool ALIGN_EPI = false, bool SP2 = false>
__device__ __forceinline__ void gemm_phase(PG8_LAS unsigned char* lds, const Gemm g, const Sched& S, const Epi& E, const int wave_id  ) {
    unsigned z_ = 0u; asm volatile("" : "+s"(z_));
    int tid_ = wave_id * 64 + (int)__builtin_amdgcn_mbcnt_hi(~0u, __builtin_amdgcn_mbcnt_lo(~0u, z_));
    const int tid = tid_, wid = __builtin_amdgcn_readfirstlane(tid >> 6), lane = tid & 63, wr = wid >> 2, wc = wid & 3, fr = lane & 15, fq = lane >> 4;
    const int K = g.K, nt = K / BK;
    unsigned voffA[2], voffB[2];
#pragma unroll
    for (int i = 0; i < 2; ++i) { int R, C; stage_rc(tid * 16 + i * 8192, R, C); const int Rb = Epi::PERM ? ((R & ~31) + perm32(R & 31)) : R;
        voffA[i] = (unsigned)(R * K + C) * 2u; voffB[i] = (unsigned)(Rb * K + C) * 2u; }
    const size_t kstep = (size_t)(BK * 2);
    const size_t hstep = (size_t)HALF * K * 2;
    const size_t tstep = 2 * hstep;
    const unsigned ldsw = (unsigned)wid * 1024u;
    const int aoff = lds_byte(wr * 64 + fr, fq * 8), boff = lds_byte(wc * 32 + fr, fq * 8);
#define PG8_SA(b, h) (((b) * 2 + (h)) * HTB)
#define PG8_SB(b, h) ((4 + (b) * 2 + (h)) * HTB)
#define PG8_STAGE(bufoff, gbase, voff) do { _Pragma("unroll") for (int _i = 0; _i < 2; ++_i) \
        __builtin_amdgcn_global_load_lds((const unsigned*)((const char*)(gbase) + (voff)[_i]), (PG8_LAS unsigned*)(lds + (bufoff) + ldsw + _i * 8192), 16, 0, 0); } while (0)
#define PG8_LDA(dst, b, h) do { _Pragma("unroll") for (int m = 0; m < 4; ++m) _Pragma("unroll") for (int k = 0; k < 2; ++k) dst[m][k] = *(const PG8_LAS bf16x8*)(lds + PG8_SA(b, h) + aoff + m * 2048 + k * 1024); } while (0)
#define PG8_LDB(dst, b, h) do { _Pragma("unroll") for (int n = 0; n < 2; ++n) _Pragma("unroll") for (int k = 0; k < 2; ++k) dst[n][k] = *(const PG8_LAS bf16x8*)(lds + PG8_SB(b, h) + boff + n * 2048 + k * 1024); } while (0)
#define PG8_MMA(ai, bj, At, Bt) do { __builtin_amdgcn_s_setprio(1); _Pragma("unroll") for (int m = 0; m < 4; ++m) _Pragma("unroll") for (int n = 0; n < 2; ++n) _Pragma("unroll") for (int k = 0; k < 2; ++k) \
        acc[ai][bj][m][n] = __builtin_amdgcn_mfma_f32_16x16x32_bf16(Bt[n][k], At[m][k], acc[ai][bj][m][n], 0, 0, 0); __builtin_amdgcn_s_setprio(0); } while (0)
#define PG8_WAIT_V(n) asm volatile("s_waitcnt vmcnt(" #n ")" ::: "memory")
#define PG8_WAIT_L(n) asm volatile("s_waitcnt lgkmcnt(" #n ")" ::: "memory")
#define PG8_BAR __builtin_amdgcn_s_barrier()
#define PG8_SCHED __builtin_amdgcn_sched_barrier(0)
    Unit cur, nxt; int ui = 0;
    if (!S.next(0, cur)) return;
    f32x4 acc[2][2][4][2];
#pragma unroll
    for (int a = 0; a < 2; ++a)
#pragma unroll
        for (int b = 0; b < 2; ++b)
#pragma unroll
            for (int m = 0; m < 4; ++m)
#pragma unroll
                for (int n = 0; n < 2; ++n) acc[a][b][m][n] = (f32x4){0.f, 0.f, 0.f, 0.f};
    bf16x8 At[4][2], B0[2][2], B1[2][2];
    const char* cA = (const char*)g.A + (size_t)cur.pm * tstep; const char* cB = (const char*)g.Bt + (size_t)cur.pn * tstep;
    S.a_ready(cur);
    if constexpr (SP2) {
        PG8_STAGE(PG8_SB(0, 0), cB, voffB); PG8_STAGE(PG8_SB(0, 1), cB + hstep, voffB); PG8_STAGE(PG8_SA(0, 0), cA, voffA); PG8_STAGE(PG8_SA(0, 1), cA + hstep, voffA);
        if (wr == 1) PG8_BAR;
        PG8_WAIT_V(2); PG8_BAR;
        PG8_STAGE(PG8_SB(1, 0), cB + kstep, voffB); PG8_STAGE(PG8_SA(1, 0), cA + kstep, voffA); PG8_STAGE(PG8_SB(1, 1), cB + hstep + kstep, voffB);
        PG8_WAIT_V(6); PG8_BAR;
    } else {
        PG8_STAGE(PG8_SB(0, 0), cB, voffB); PG8_STAGE(PG8_SA(0, 0), cA, voffA); PG8_STAGE(PG8_SB(0, 1), cB + hstep, voffB); PG8_STAGE(PG8_SA(0, 1), cA + hstep, voffA);
        if (wr == 1) PG8_BAR;
        PG8_WAIT_V(4); PG8_BAR;
        PG8_STAGE(PG8_SB(1, 0), cB + kstep, voffB); PG8_STAGE(PG8_SA(1, 0), cA + kstep, voffA); PG8_STAGE(PG8_SB(1, 1), cB + hstep + kstep, voffB);
        PG8_WAIT_V(6); PG8_BAR;
    }
    for (;;) {
        const bool has_next = S.next(ui + 1, nxt);
        const char* nA = has_next ? (const char*)g.A + (size_t)nxt.pm * tstep : cA; const char* nB = has_next ? (const char*)g.Bt + (size_t)nxt.pn * tstep : cB;
        for (int t = 0; t < nt; t += 2) {
            const bool last = (t == nt - 2);
            const char* a1 = cA + (size_t)(t + 1) * kstep;
            const char* a2 = last ? nA : cA + (size_t)(t + 2) * kstep; const char* b2 = last ? nB : cB + (size_t)(t + 2) * kstep;
            const char* a3 = a2 + kstep; const char* b3 = b2 + kstep;
            if (last && has_next) S.a_ready(nxt);
            if constexpr (SP2) {
            PG8_LDB(B0, 0, 0); PG8_LDB(B1, 0, 1); PG8_SCHED; PG8_LDA(At, 0, 0); PG8_STAGE(PG8_SA(1, 1), a1 + hstep, voffA);
            PG8_WAIT_V(8); PG8_WAIT_L(0); PG8_BAR; PG8_MMA(0, 0, At, B0); PG8_MMA(0, 1, At, B1); PG8_BAR; PG8_SCHED;
            PG8_LDA(At, 0, 1); PG8_STAGE(PG8_SB(0, 0), b2, voffB); PG8_STAGE(PG8_SB(0, 1), b2 + hstep, voffB); PG8_STAGE(PG8_SA(0, 0), a2, voffA);
            PG8_WAIT_V(8); PG8_WAIT_L(0); PG8_BAR; PG8_MMA(1, 0, At, B0); PG8_MMA(1, 1, At, B1); PG8_BAR; PG8_SCHED;
            PG8_LDB(B0, 1, 0); PG8_LDB(B1, 1, 1); PG8_SCHED; PG8_LDA(At, 1, 0); PG8_STAGE(PG8_SA(0, 1), a2 + hstep, voffA);
            PG8_WAIT_V(8); PG8_WAIT_L(0); PG8_BAR; PG8_MMA(0, 0, At, B0); PG8_MMA(0, 1, At, B1); PG8_BAR; PG8_SCHED;
            PG8_LDA(At, 1, 1); PG8_STAGE(PG8_SB(1, 0), b3, voffB); PG8_STAGE(PG8_SB(1, 1), b3 + hstep, voffB); PG8_STAGE(PG8_SA(1, 0), a3, voffA);
            PG8_WAIT_V(8); PG8_WAIT_L(0); PG8_BAR; PG8_MMA(1, 0, At, B0); PG8_MMA(1, 1, At, B1); PG8_BAR; PG8_SCHED;
            } else {
            PG8_LDB(B0, 0, 0); PG8_SCHED; PG8_LDA(At, 0, 0); PG8_STAGE(PG8_SA(1, 1), a1 + hstep, voffA);
            PG8_WAIT_L(8); PG8_BAR; PG8_WAIT_L(0); PG8_MMA(0, 0, At, B0); PG8_BAR; PG8_SCHED;
            PG8_LDB(B1, 0, 1); PG8_STAGE(PG8_SB(0, 0), b2, voffB);
            PG8_BAR; PG8_WAIT_L(0); PG8_MMA(0, 1, At, B1); PG8_BAR;
            PG8_LDA(At, 0, 1); PG8_STAGE(PG8_SA(0, 0), a2, voffA);
            PG8_BAR; PG8_WAIT_L(0); PG8_MMA(1, 0, At, B0); PG8_BAR; PG8_SCHED;
            PG8_STAGE(PG8_SB(0, 1), b2 + hstep, voffB);
            PG8_WAIT_V(6); PG8_BAR; PG8_MMA(1, 1, At, B1); PG8_BAR;
            PG8_LDB(B0, 1, 0); PG8_SCHED; PG8_LDA(At, 1, 0); PG8_STAGE(PG8_SA(0, 1), a2 + hstep, voffA);
            PG8_WAIT_L(8); PG8_BAR; PG8_WAIT_L(0); PG8_MMA(0, 0, At, B0); PG8_BAR; PG8_SCHED;
            PG8_LDB(B1, 1, 1); PG8_STAGE(PG8_SB(1, 0), b3, voffB);
            PG8_BAR; PG8_WAIT_L(0); PG8_MMA(0, 1, At, B1); PG8_BAR;
            PG8_LDA(At, 1, 1); PG8_STAGE(PG8_SA(1, 0), a3, voffA);
            PG8_BAR; PG8_WAIT_L(0); PG8_MMA(1, 0, At, B0); PG8_BAR; PG8_SCHED;
            PG8_STAGE(PG8_SB(1, 1), b3 + hstep, voffB);
            PG8_WAIT_V(6); PG8_BAR; PG8_MMA(1, 1, At, B1); PG8_BAR;
            }
        }
        if constexpr (ALIGN_EPI) { if (wr == 0) PG8_BAR; }
        if constexpr (!Epi::AFTER_DRAIN) { E(acc, cur, wr, wc, fr, fq); S.done(cur); }
        if (!has_next) break;
#pragma unroll
        for (int a = 0; a < 2; ++a)
#pragma unroll
            for (int b = 0; b < 2; ++b)
#pragma unroll
                for (int m = 0; m < 4; ++m)
#pragma unroll
                    for (int n = 0; n < 2; ++n) acc[a][b][m][n] = (f32x4){0.f, 0.f, 0.f, 0.f};
        cur = nxt; cA = nA; cB = nB; ++ui;
        if constexpr (ALIGN_EPI) { if (wr == 1) PG8_BAR; }
    }
    PG8_WAIT_V(0);
    if constexpr (!ALIGN_EPI) { if (wr == 0) PG8_BAR; }
    PG8_BAR;
    if constexpr (Epi::AFTER_DRAIN) { E.fused(acc, cur, wr, wc, fr, fq, lds, wid, lane); S.done(cur); }
#undef PG8_SA
#undef PG8_SB
#undef PG8_STAGE
#undef PG8_LDA
#undef PG8_LDB
#undef PG8_MMA
#undef PG8_WAIT_V
#undef PG8_WAIT_L
#undef PG8_BAR
#undef PG8_SCHED
}
}

constexpr int NWAVES = 8;
constexpr int BATCH = 8, SEQ = 4096, DM = 2048, DEPTH = 4, M = BATCH * SEQ;
constexpr int INW = 5376, DFF = 5632, NGU = 2 * DFF, XW = 512, MEML = 256, MROWS = BATCH * MEML;
constexpr int QA = 0, KA = 512, VA = 640, QB = 768, KB = 1280, VB = 1792, QC = 2304, KC = 3328, VC = 4352;
constexpr float LOG2E = 1.4426950408889634f;
constexpr float C2 = 0.125f * LOG2E;
constexpr float CX2 = 0.08838834764831845f * LOG2E;
constexpr float EPS = 1e-5f;

constexpr size_t MiB = 1u << 20;
constexpr size_t WS_CTL = 0, CTL_ZERO_BYTES = 4 * MiB;
constexpr size_t WS_KMEAN = 1 * MiB;
constexpr size_t WS_WL = 4 * MiB, WL_STRIDE = 99 * MiB;
constexpr size_t WL_IN = 0, WL_OUT = 21 * MiB, WL_Q = 29 * MiB, WL_O = 31 * MiB, WL_GU = 33 * MiB, WL_DN = 77 * MiB;
constexpr size_t WS_WKV = 400 * MiB;
constexpr size_t WS_KVX = 416 * MiB;
constexpr size_t WS_XN = 432 * MiB;
constexpr size_t WS_BIG = 560 * MiB;
constexpr size_t WS_QX = WS_XN, WS_OX = WS_XN + 32 * MiB;
constexpr size_t WS_PART = 912 * MiB;
constexpr size_t WS_LSE = WS_PART + 128 * MiB;
constexpr size_t WS_SS = WS_LSE + 6 * MiB, SS_BYTES = 13 * 32768 * 8;
constexpr size_t WS_MEMN = WS_SS + 4 * MiB;
constexpr size_t WS_END = WS_MEMN + 32 * MiB;
static_assert((size_t)INW * DM * 2 == 21 * MiB && (size_t)NGU * DM * 2 == 44 * MiB && (size_t)DM * DFF * 2 == 22 * MiB, "weight map");
static_assert((size_t)M * DFF * 2 == 352 * MiB, "big buffer");
constexpr int CW_TMO = 0;
constexpr int CW_BAR = 4096;
constexpr int RING_OFF = 0, RING_BYTES = 131072;
constexpr int LDSCTL_OFF = RING_BYTES, MISC_OFF = LDSCTL_OFF + 320;
constexpr int LDS_BYTES = 147456;

#define GAS __attribute__((address_space(1)))
#define LAS __attribute__((address_space(3)))
typedef unsigned short bf16;
typedef unsigned v4u __attribute__((ext_vector_type(4)));
typedef unsigned v2u __attribute__((ext_vector_type(2)));
typedef float f32x4 __attribute__((ext_vector_type(4)));
typedef GAS unsigned gu32;
#define RLX_AGENT __ATOMIC_RELAXED, __HIP_MEMORY_SCOPE_AGENT
#define LDS_WAIT() asm volatile("s_waitcnt lgkmcnt(0)" ::: "memory")
__device__ __forceinline__ unsigned f2bf(float f) { unsigned u = __builtin_bit_cast(unsigned, f); return (u + 0x7fffu + ((u >> 16) & 1u)) >> 16; }
typedef float pk_f32x2 __attribute__((ext_vector_type(2)));
typedef __bf16 pk_bf16x2 __attribute__((ext_vector_type(2)));
__device__ __forceinline__ unsigned pk2(float lo, float hi) { pk_f32x2 v = {lo, hi}; return __builtin_bit_cast(unsigned, __builtin_convertvector(v, pk_bf16x2)); }
__device__ __forceinline__ float bflo(unsigned w) { return __builtin_bit_cast(float, w << 16); }
__device__ __forceinline__ float bfhi(unsigned w) { return __builtin_bit_cast(float, w & 0xffff0000u); }
__device__ __forceinline__ float bf1(bf16 x) { return __builtin_bit_cast(float, (unsigned)x << 16); }
__device__ __forceinline__ float ex2(float x) { return __builtin_amdgcn_exp2f(x); }
#define XB_TMO      128
#define XB_XCNT(j)  (256  + 64 * (j))
#define XB_XSUB(j)  (1280 + 64 * (j))
#define XB_XGEN(j)  (2304 + 64 * (j))
#define XB_TOP      3328
#define XB_TOPGEN   3392
#define XCD_BAR_WORDS 3456
#define XB_SPIN_CAP (1u << 18)

__device__ __forceinline__ unsigned xb_ld(unsigned* p)              { return __hip_atomic_load(p, __ATOMIC_RELAXED, __HIP_MEMORY_SCOPE_AGENT); }
__device__ __forceinline__ unsigned xb_add(unsigned* p, unsigned v) { return __hip_atomic_fetch_add(p, v, __ATOMIC_RELAXED, __HIP_MEMORY_SCOPE_AGENT); }
__device__ __forceinline__ unsigned xb_xcc_id() { return (unsigned)__builtin_amdgcn_s_getreg((3 << 11) | 20) & 0xFu; }
#define XB_SPIN(cond, bar) do { unsigned _sp = 0; while (cond) { __builtin_amdgcn_s_sleep(1); \
    if ((++_sp & 255u) == 0u) { if (xb_ld(&(bar)[XB_TMO])) break; if (_sp > XB_SPIN_CAP) { atomicAdd(&(bar)[XB_TMO], 1u); break; } } } } while (0)

struct XcdBarrier {
    unsigned* bar; unsigned x;
    volatile LAS unsigned* st;
};

__device__ __forceinline__ XcdBarrier xcd_barrier_post(unsigned* bar, volatile LAS unsigned* st) {
    XcdBarrier b; b.bar = bar; b.x = xb_xcc_id(); b.st = st;
    if (threadIdx.x == 0) (void)xb_add(&bar[XB_XCNT(b.x)], 1u);
    return b;
}
__device__ __forceinline__ void xcd_barrier_complete(unsigned* bar, unsigned x, unsigned& nloc, unsigned& nx) {
    const unsigned G = gridDim.x * gridDim.y * gridDim.z;
    unsigned sum, cnt, mine, sp = 0u;
    for (;;) {
        sum = 0u; cnt = 0u; mine = 0u;
#pragma unroll
        for (unsigned j = 0; j < 16; ++j) { const unsigned c = xb_ld(&bar[XB_XCNT(j)]); sum += c; cnt += (c > 0u) ? 1u : 0u; mine = (j == x) ? c : mine; }
        if (sum == G) break;
        __builtin_amdgcn_s_sleep(1);
        if ((++sp & 255u) == 0u) { if (xb_ld(&bar[XB_TMO])) break; if (sp > XB_SPIN_CAP) { atomicAdd(&bar[XB_TMO], 1u); break; } }
    }
    nloc = mine > 0u ? mine : 1u; nx = cnt > 0u ? cnt : 1u;
}

__device__ __forceinline__ void xcd_barrier(const XcdBarrier& b) {
    asm volatile("s_waitcnt vmcnt(0)" ::: "memory");
    __syncthreads();
    if (threadIdx.x == 0) {
        unsigned* bar = b.bar;
        __builtin_amdgcn_s_waitcnt(0);
        unsigned nloc = b.st[0], nx = b.st[1];
        if (nloc == 0u) { xcd_barrier_complete(bar, b.x, nloc, nx); b.st[0] = nloc; b.st[1] = nx; }
        const unsigned old = xb_add(&bar[XB_XSUB(b.x)], 1u);
        const unsigned gen = old / nloc;
        if (old + 1u == (gen + 1u) * nloc) {
            __builtin_amdgcn_fence(__ATOMIC_RELEASE, "agent");
            asm volatile("s_waitcnt vmcnt(0)" ::: "memory");
            const unsigned og = xb_add(&bar[XB_TOP], 1u);
            const unsigned tg = og / nx;
            if (og + 1u == (tg + 1u) * nx) xb_add(&bar[XB_TOPGEN], 1u);
            else XB_SPIN(xb_ld(&bar[XB_TOPGEN]) == tg, bar);
            __builtin_amdgcn_fence(__ATOMIC_ACQUIRE, "agent");
            xb_add(&bar[XB_XGEN(b.x)], 1u);
            asm volatile("s_waitcnt vmcnt(0)" ::: "memory");
        } else {
            XB_SPIN(xb_ld(&bar[XB_XGEN(b.x)]) == gen, bar);
            __builtin_amdgcn_fence(__ATOMIC_ACQUIRE, "agent");
            asm volatile("s_waitcnt vmcnt(0)" ::: "memory");
        }
    }
    __syncthreads();
}

__device__ __forceinline__ unsigned xcd_barrier_post_rank(unsigned* bar, unsigned x) { return xb_add(&bar[XB_XCNT(x)], 1u); }
__device__ __forceinline__ void xcd_barrier2(const XcdBarrier& b, const bool team) {
    asm volatile("s_waitcnt vmcnt(0)" ::: "memory");
    __syncthreads();
    if (threadIdx.x == 0) {
        unsigned* bar = b.bar;
        __builtin_amdgcn_s_waitcnt(0);
        unsigned nloc = b.st[0], nx = b.st[1];
        if (nloc == 0u) { xcd_barrier_complete(bar, b.x, nloc, nx); b.st[0] = nloc; b.st[1] = nx; }
        const unsigned old = xb_add(&bar[XB_XSUB(b.x)], 1u);
        const unsigned gen = old / nloc;
        if (old + 1u == (gen + 1u) * nloc) {
            if (!team) {
                __builtin_amdgcn_fence(__ATOMIC_RELEASE, "agent");
                asm volatile("s_waitcnt vmcnt(0)" ::: "memory");
                const unsigned og = xb_add(&bar[XB_TOP], 1u);
                const unsigned tg = og / nx;
                if (og + 1u == (tg + 1u) * nx) xb_add(&bar[XB_TOPGEN], 1u);
                else XB_SPIN(xb_ld(&bar[XB_TOPGEN]) == tg, bar);
            }
            __builtin_amdgcn_fence(__ATOMIC_ACQUIRE, "agent");
            xb_add(&bar[XB_XGEN(b.x)], 1u);
            asm volatile("s_waitcnt vmcnt(0)" ::: "memory");
        } else {
            XB_SPIN(xb_ld(&bar[XB_XGEN(b.x)]) == gen, bar);
            __builtin_amdgcn_fence(__ATOMIC_ACQUIRE, "agent");
            asm volatile("s_waitcnt vmcnt(0)" ::: "memory");
        }
    }
    __syncthreads();
}

__device__ __forceinline__ float wave_sum(float v) {
    return sum_x32(sum_x16(sum_row16(v)));
}
typedef short tr_v4i16 __attribute__((ext_vector_type(4)));
__device__ __forceinline__ void transpose_item(const float* W, int K, int N, bf16* WT, int dst_row0, int k0, int n0, LAS char* scr, int lane, const float* gk = nullptr) {
    const int i16 = lane & 15, g = lane >> 4;
    f32x4 w[16];
#pragma unroll
    for (int i = 0; i < 16; ++i) w[i] = __builtin_nontemporal_load((const GAS f32x4*)(W + (size_t)(k0 + 4 * i + g) * N + n0 + 4 * i16));
#pragma unroll
    for (int i = 0; i < 16; ++i) { const int kk = 4 * i + g; f32x4 x = w[i]; if (gk) x = x * gk[k0 + kk];
        v2u p; p.x = pk2(x.x, x.y); p.y = pk2(x.z, x.w); *(LAS v2u*)(scr + kk * 144 + i16 * 8) = p; }
    LDS_WAIT(); asm volatile("" ::: "memory");
    const int q = i16 >> 2, pp = i16 & 3;
#pragma unroll
    for (int p = 0; p < 8; ++p) { const int c8 = (p & 1) * 4 + g, nb = p >> 1;
        LAS const char* src = scr + (8 * c8 + q) * 144 + nb * 32 + pp * 8;
        const tr_v4i16 lo = __builtin_amdgcn_ds_read_tr16_b64_v4i16((LAS tr_v4i16*)src), hi = __builtin_amdgcn_ds_read_tr16_b64_v4i16((LAS tr_v4i16*)(src + 4 * 144));
        v4u o; const v2u l2 = __builtin_bit_cast(v2u, lo), h2 = __builtin_bit_cast(v2u, hi); o.x = l2.x; o.y = l2.y; o.z = h2.x; o.w = h2.y;
        *(GAS v4u*)(WT + (size_t)(dst_row0 + nb * 16 + i16) * K + k0 + 8 * c8) = o; }
    LDS_WAIT(); asm volatile("" ::: "memory");
}
__device__ __forceinline__ float row_load_ss(const float* xrow, int lane, f32x4 (&v)[8]) {
    const GAS f32x4* xr = (const GAS f32x4*)xrow + lane; float s = 0.f;
#pragma unroll
    for (int j = 0; j < 8; ++j) { v[j] = xr[64 * j]; s += (v[j].x * v[j].x + v[j].y * v[j].y) + (v[j].z * v[j].z + v[j].w * v[j].w); }
    return wave_sum(s);
}
__device__ __forceinline__ void row_store_bf16(bf16* orow, int lane, const f32x4 (&v)[8], const f32x4 (&g)[8], float rstd) {
    GAS unsigned long long* o8 = (GAS unsigned long long*)orow + lane;
#pragma unroll
    for (int j = 0; j < 8; ++j) o8[64 * j] = (unsigned long long)pk2(v[j].x * rstd * g[j].x, v[j].y * rstd * g[j].y) | ((unsigned long long)pk2(v[j].z * rstd * g[j].z, v[j].w * rstd * g[j].w) << 32);
}
__device__ __forceinline__ void load_gain(const float* g, int lane, f32x4 (&gv)[8]) {
    const GAS f32x4* gr = (const GAS f32x4*)g + lane;
#pragma unroll
    for (int j = 0; j < 8; ++j) gv[j] = gr[64 * j];
}
__device__ __forceinline__ void norm_rows_phase(const float* X, const float* g, bf16* XN, int gw, int NGW, int lane) {
    f32x4 gv[8]; load_gain(g, lane, gv);
    for (int m = gw; m < M; m += NGW) { f32x4 v[8]; const float ss = row_load_ss(X + (size_t)m * DM, lane, v);
        const float rstd = 1.f / sqrtf(ss * (1.f / DM) + EPS); row_store_bf16(XN + (size_t)m * DM, lane, v, gv, rstd); }
}

struct Ptrs {
    const float *x, *mem, *norm_mix, *w_in, *sinks, *gain_a, *gain_b, *gain_c, *w_out, *norm_xattn, *norm_mem, *wq_x, *wk_x, *wv_x, *wo_x, *norm_ffn, *w_gate, *w_up, *w_down, *norm_final;
};
constexpr int IT_IN = 32 * 84, IT_OUT = 32 * 32, IT_Q = 32 * 8, IT_O = 8 * 32, IT_G = 32 * 88, IT_DN = 88 * 32;
constexpr int IT_LAYER = IT_IN + IT_OUT + 3 * IT_Q + IT_O + 2 * IT_G + IT_DN;
__device__ __forceinline__ void p0_convert(const Ptrs& P, unsigned char* ws, bf16* H16, LAS char* scr, int gw, int NGW, int lane) {
    for (int it = gw; it < DEPTH * IT_LAYER; it += NGW) {
        const int l = it / IT_LAYER; int r = it % IT_LAYER;
        unsigned char* wl = ws + WS_WL + (size_t)l * WL_STRIDE;
        if (r < IT_IN) { transpose_item(P.w_in + (size_t)l * DM * INW, DM, INW, (bf16*)(wl + WL_IN), (r % 84) * 64, (r / 84) * 64, (r % 84) * 64, scr, lane, P.norm_mix + l * DM); continue; } r -= IT_IN;
        if (r < IT_OUT) { transpose_item(P.w_out + (size_t)l * DM * DM, DM, DM, (bf16*)(wl + WL_OUT), (r % 32) * 64, (r / 32) * 64, (r % 32) * 64, scr, lane); continue; } r -= IT_OUT;
        if (r < IT_Q) { transpose_item(P.wq_x + (size_t)l * DM * XW, DM, XW, (bf16*)(wl + WL_Q), (r % 8) * 64, (r / 8) * 64, (r % 8) * 64, scr, lane, P.norm_xattn + l * DM); continue; } r -= IT_Q;
        if (r < IT_Q) { transpose_item(P.wk_x + (size_t)l * DM * XW, DM, XW, (bf16*)(ws + WS_WKV) + (size_t)l * 1024 * DM, (r % 8) * 64, (r / 8) * 64, (r % 8) * 64, scr, lane); continue; } r -= IT_Q;
        if (r < IT_Q) { transpose_item(P.wv_x + (size_t)l * DM * XW, DM, XW, (bf16*)(ws + WS_WKV) + (size_t)l * 1024 * DM, 512 + (r % 8) * 64, (r / 8) * 64, (r % 8) * 64, scr, lane); continue; } r -= IT_Q;
        if (r < IT_O) { transpose_item(P.wo_x + (size_t)l * XW * DM, XW, DM, (bf16*)(wl + WL_O), (r % 32) * 64, (r / 32) * 64, (r % 32) * 64, scr, lane); continue; } r -= IT_O;
        if (r < IT_G) { const int n0 = (r % 88) * 64; transpose_item(P.w_gate + (size_t)l * DM * DFF, DM, DFF, (bf16*)(wl + WL_GU), 256 * (n0 >> 7) + (n0 & 127), (r / 88) * 64, n0, scr, lane, P.norm_ffn + l * DM); continue; } r -= IT_G;
        if (r < IT_G) { const int n0 = (r % 88) * 64; transpose_item(P.w_up + (size_t)l * DM * DFF, DM, DFF, (bf16*)(wl + WL_GU), 256 * (n0 >> 7) + 128 + (n0 & 127), (r / 88) * 64, n0, scr, lane, P.norm_ffn + l * DM); continue; } r -= IT_G;
        transpose_item(P.w_down + (size_t)l * DFF * DM, DFF, DM, (bf16*)(wl + WL_DN), (r % 32) * 64, (r / 32) * 64, (r % 32) * 64, scr, lane);
    }
    for (int m = gw; m < MROWS; m += NGW) { f32x4 v[8]; const float ss = row_load_ss(P.mem + (size_t)m * DM, lane, v); const float rstd = 1.f / sqrtf(ss * (1.f / DM) + EPS);
        for (int l = 0; l < DEPTH; ++l) { f32x4 gv[8]; load_gain(P.norm_mem + l * DM, lane, gv); row_store_bf16((bf16*)(ws + WS_MEMN) + ((size_t)l * MROWS + m) * DM, lane, v, gv, rstd); } }
    { unsigned long long* ss0 = (unsigned long long*)(ws + WS_SS); f32x4 one[8];
#pragma unroll
      for (int j = 0; j < 8; ++j) one[j] = (f32x4){1.f, 1.f, 1.f, 1.f};
      for (int m = gw; m < M; m += 2 * NGW) { f32x4 v[2][8];
#pragma unroll
          for (int q = 0; q < 2; ++q) { const GAS f32x4* xr = (const GAS f32x4*)(P.x + (size_t)(m + q * NGW) * DM) + lane;
#pragma unroll
              for (int j = 0; j < 8; ++j) v[q][j] = xr[64 * j]; }
#pragma unroll
          for (int q = 0; q < 2; ++q) { const int mq = m + q * NGW; float s = 0.f;
#pragma unroll
              for (int j = 0; j < 8; ++j) s += (v[q][j].x * v[q][j].x + v[q][j].y * v[q][j].y) + (v[q][j].z * v[q][j].z + v[q][j].w * v[q][j].w);
              const float ss = wave_sum(s); row_store_bf16(H16 + (size_t)mq * DM, lane, v[q], one, 1.f);
              if (lane == 0) { const unsigned hi_ = (unsigned)ss, lo_ = (unsigned)((ss - (float)hi_) * 4294967296.f); ss0[mq] = ((unsigned long long)hi_ << 32) | lo_; } } } }
}

__device__ __forceinline__ void kmean_phase(const bf16* PJ, float* KM, int gw, int NGW, int lane) {
    for (int it = gw; it < (M / 256) * 8; it += NGW) { const int pm = it >> 3, h = it & 7; const bf16* p = PJ + (size_t)pm * 256 * INW + KB + h * 64 + lane; float s = 0.f;
#pragma unroll 8
        for (int r = 0; r < 256; ++r) s += bf1(p[(size_t)r * INW]);
        KM[pm * 512 + h * 64 + lane] = s; }
}

__device__ __forceinline__ float dot8(v4u a, v4u b, float acc) {
    acc = fmaf(bflo(a.x), bflo(b.x), acc); acc = fmaf(bfhi(a.x), bfhi(b.x), acc); acc = fmaf(bflo(a.y), bflo(b.y), acc); acc = fmaf(bfhi(a.y), bfhi(b.y), acc);
    acc = fmaf(bflo(a.z), bflo(b.z), acc); acc = fmaf(bfhi(a.z), bfhi(b.z), acc); acc = fmaf(bflo(a.w), bflo(b.w), acc); acc = fmaf(bfhi(a.w), bfhi(b.w), acc); return acc;
}
struct Soft64 { float m, l; float o[64]; };
#define SOFT64_KEY(S, sc_, vrow_) do { const float _sc = (sc_); if (_sc > S.m) { const float _a = ex2(S.m - _sc); S.l *= _a; _Pragma("unroll") for (int _d = 0; _d < 64; ++_d) S.o[_d] *= _a; S.m = _sc; } \
    const float _p = ex2(_sc - S.m); S.l += _p; const GAS v4u* _v = (const GAS v4u*)(vrow_); \
    _Pragma("unroll") for (int _i = 0; _i < 8; ++_i) { const v4u _w = _v[_i]; S.o[8 * _i + 0] = fmaf(_p, bflo(_w.x), S.o[8 * _i + 0]); S.o[8 * _i + 1] = fmaf(_p, bfhi(_w.x), S.o[8 * _i + 1]); \
        S.o[8 * _i + 2] = fmaf(_p, bflo(_w.y), S.o[8 * _i + 2]); S.o[8 * _i + 3] = fmaf(_p, bfhi(_w.y), S.o[8 * _i + 3]); S.o[8 * _i + 4] = fmaf(_p, bflo(_w.z), S.o[8 * _i + 4]); S.o[8 * _i + 5] = fmaf(_p, bfhi(_w.z), S.o[8 * _i + 5]); \
        S.o[8 * _i + 6] = fmaf(_p, bflo(_w.w), S.o[8 * _i + 6]); S.o[8 * _i + 7] = fmaf(_p, bfhi(_w.w), S.o[8 * _i + 7]); } } while (0)
#define QK64(qw_, krow_, out_) do { const GAS v4u* _k = (const GAS v4u*)(krow_); float _a0 = 0.f, _a1 = 0.f; _Pragma("unroll") for (int _i = 0; _i < 8; _i += 2) { _a0 = dot8(qw_[_i], _k[_i], _a0); _a1 = dot8(qw_[_i + 1], _k[_i + 1], _a1); } out_ = _a0 + _a1; } while (0)
#define STORE_O64(S, orow_) do { const float _rl = 1.f / S.l; GAS v4u* _o = (GAS v4u*)(orow_); _Pragma("unroll") for (int _i = 0; _i < 8; ++_i) { v4u _w; _w.x = pk2(S.o[8 * _i] * _rl, S.o[8 * _i + 1] * _rl); _w.y = pk2(S.o[8 * _i + 2] * _rl, S.o[8 * _i + 3] * _rl); \
        _w.z = pk2(S.o[8 * _i + 4] * _rl, S.o[8 * _i + 5] * _rl); _w.w = pk2(S.o[8 * _i + 6] * _rl, S.o[8 * _i + 7] * _rl); _o[_i] = _w; } } while (0)

__device__ __forceinline__ void naive_attn_a(const bf16* PJ, const float* sinks, bf16* O, int gtid, int nthr) {
    for (int it = gtid; it < 8 * M; it += nthr) { const int h = it / M, m = it % M, t = m & (SEQ - 1), kvh = h >> 2;
        v4u qw[8]; { const GAS v4u* q = (const GAS v4u*)(PJ + (size_t)m * INW + QA + h * 64);
#pragma unroll
            for (int i = 0; i < 8; ++i) qw[i] = q[i]; }
        const float slope2 = ex2(-(float)(h + 1)) * LOG2E;
        Soft64 S; S.m = sinks[h] * LOG2E; S.l = 1.f;
#pragma unroll
        for (int d = 0; d < 64; ++d) S.o[d] = 0.f;
        const int nk = t < 127 ? t + 1 : 128;
        for (int dist = 0; dist < nk; ++dist) { const bf16* kr = PJ + (size_t)(m - dist) * INW + KA + kvh * 64; float sc; QK64(qw, kr, sc); sc -= slope2 * (float)dist;
            SOFT64_KEY(S, sc, kr + (VA - KA)); }
        STORE_O64(S, O + (size_t)m * DM + h * 64); }
}
__device__ __forceinline__ void naive_attn_b(const bf16* PJ, const float* KM, bf16* O, int gtid, int nthr) {
    for (int it = gtid; it < 8 * M; it += nthr) { const int h = it / M, m = it % M, t = m & (SEQ - 1), blk = t >> 8, pm0 = (m >> 12) << 4;
        v4u qw[8]; { const GAS v4u* q = (const GAS v4u*)(PJ + (size_t)m * INW + QB + h * 64);
#pragma unroll
            for (int i = 0; i < 8; ++i) qw[i] = q[i]; }
        const float slope2 = ex2(-(float)(h + 1)) * LOG2E;
        float g1 = -INFINITY, g2 = -INFINITY, g3 = -INFINITY; int i1 = -1, i2 = -1, i3 = -1;
        for (int n = 0; n < blk; ++n) { const GAS f32x4* km = (const GAS f32x4*)(KM + (size_t)(pm0 + n) * 512 + h * 64); float g = 0.f;
#pragma unroll
            for (int i = 0; i < 8; ++i) { const f32x4 a = km[2 * i], b = km[2 * i + 1]; const v4u w = qw[i];
                g = fmaf(bflo(w.x), a.x, g); g = fmaf(bfhi(w.x), a.y, g); g = fmaf(bflo(w.y), a.z, g); g = fmaf(bfhi(w.y), a.w, g);
                g = fmaf(bflo(w.z), b.x, g); g = fmaf(bfhi(w.z), b.y, g); g = fmaf(bflo(w.w), b.z, g); g = fmaf(bfhi(w.w), b.w, g); }
            if (g > g1) { g3 = g2; i3 = i2; g2 = g1; i2 = i1; g1 = g; i1 = n; } else if (g > g2) { g3 = g2; i3 = i2; g2 = g; i2 = n; } else if (g > g3) { g3 = g; i3 = n; } }
        Soft64 S; S.m = -1e30f; S.l = 0.f;
#pragma unroll
        for (int d = 0; d < 64; ++d) S.o[d] = 0.f;
        const int mb = m - t;
        for (int s = 0; s < 4; ++s) { const int n = (s == 0) ? blk : (s == 1 ? i1 : (s == 2 ? i2 : i3)); if (n < 0) continue;
            const int p0 = n * 256, nk = (s == 0) ? (t - p0 + 1) : 256;
            for (int j = 0; j < nk; ++j) { const int pos = p0 + j; const bf16* kr = PJ + (size_t)(mb + pos) * INW + KB + h * 64; float sc; QK64(qw, kr, sc); sc -= slope2 * (float)(t - pos);
                SOFT64_KEY(S, sc, kr + (VB - KB)); } }
        STORE_O64(S, O + (size_t)m * DM + 512 + h * 64); }
}
__device__ __forceinline__ void naive_attn_c(const bf16* PJ, bf16* O, int gtid, int nthr) {
    for (int it = gtid; it < 16 * M; it += nthr) { const int h = it / M, m = it % M, t = m & (SEQ - 1);
        v4u qw[8]; { const GAS v4u* q = (const GAS v4u*)(PJ + (size_t)m * INW + QC + h * 64);
#pragma unroll
            for (int i = 0; i < 8; ++i) qw[i] = q[i]; }
        const float slope2 = ex2(-0.5f * (float)(h + 1)) * LOG2E;
        Soft64 S; S.m = -1e30f; S.l = 0.f;
#pragma unroll
        for (int d = 0; d < 64; ++d) S.o[d] = 0.f;
        for (int br = 0; br < 3; ++br) { const int dd = (br == 0) ? 1 : (br == 1 ? 4 : 16);
            for (int step = 0; step <= 128; ++step) { const int dist = step * dd; if (dist > t) break;
                const bf16* kr = PJ + (size_t)(m - dist) * INW + KC + h * 64; float sc; QK64(qw, kr, sc); sc -= slope2 * (float)dist;
                SOFT64_KEY(S, sc, kr + (VC - KC)); } }
        STORE_O64(S, O + (size_t)m * DM + 1024 + h * 64); }
}
__device__ __forceinline__ void naive_attn_x(const bf16* QX, const bf16* KVX  , bf16* OX, int gtid, int nthr) {
    for (int it = gtid; it < 8 * M; it += nthr) { const int hh = it / M, m = it % M, h = hh >> 1, half = hh & 1, b = m >> 12;
        v4u qw[16]; { const GAS v4u* q = (const GAS v4u*)(QX + (size_t)m * XW + h * 128);
#pragma unroll
            for (int i = 0; i < 16; ++i) qw[i] = q[i]; }
        Soft64 S; S.m = -1e30f; S.l = 0.f;
#pragma unroll
        for (int d = 0; d < 64; ++d) S.o[d] = 0.f;
        for (int j = 0; j < MEML; ++j) { const bf16* kr = KVX + (size_t)(b * MEML + j) * 1024 + h * 128; const GAS v4u* k = (const GAS v4u*)kr; float a0 = 0.f, a1 = 0.f;
#pragma unroll
            for (int i = 0; i < 16; i += 2) { a0 = dot8(qw[i], k[i], a0); a1 = dot8(qw[i + 1], k[i + 1], a1); }
            SOFT64_KEY(S, a0 + a1, kr + 512 + half * 64); }
        STORE_O64(S, OX + (size_t)m * XW + h * 128 + half * 64); }
}
template <bool MERGE>
__device__ __forceinline__ void ynorm_phase(bf16* Y, bf16* YO  , const bf16* PART, const float* LSE, const float* ga, const float* gb, const float* gc, int row_lo, int row_hi, int row_step, int lane) {
    f32x4 g[4][2];
#pragma unroll
    for (int j = 0; j < 4; ++j) { const float* gp = (j == 0) ? ga : (j == 1 ? gb : gc + (j - 2) * 512); g[j][0] = *(const GAS f32x4*)(gp + 8 * lane); g[j][1] = *(const GAS f32x4*)(gp + 8 * lane + 4); }
    struct YR { v4u w[4], p1[2], p2[2]; float l0[2], l1[2], l2[2]; };
    auto load = [&](YR& R, int m) { GAS v4u* row = (GAS v4u*)(Y + (size_t)m * DM) + lane;
#pragma unroll
        for (int j = 0; j < 4; ++j) R.w[j] = row[64 * j];
        if (MERGE) {
#pragma unroll
            for (int jj = 0; jj < 2; ++jj) { const int hc = 8 * jj + (lane >> 3); R.l0[jj] = LSE[(size_t)m * 16 + hc]; R.l1[jj] = LSE[(size_t)(M + m) * 16 + hc]; R.l2[jj] = LSE[(size_t)(2 * M + m) * 16 + hc];
                R.p1[jj] = *(const GAS v4u*)(PART + (size_t)m * 1024 + 512 * jj + 8 * lane); R.p2[jj] = *(const GAS v4u*)(PART + (size_t)(M + m) * 1024 + 512 * jj + 8 * lane); } } };
    auto finish = [&](const YR& R, int m) { float v[4][8], ss[4];
#pragma unroll
        for (int j = 0; j < 4; ++j) { const v4u w = R.w[j]; v[j][0] = bflo(w.x); v[j][1] = bfhi(w.x); v[j][2] = bflo(w.y); v[j][3] = bfhi(w.y); v[j][4] = bflo(w.z); v[j][5] = bfhi(w.z); v[j][6] = bflo(w.w); v[j][7] = bfhi(w.w);
            if (MERGE && j >= 2) { const float l0 = R.l0[j - 2], l1 = R.l1[j - 2], l2 = R.l2[j - 2];
                const float mx = fmaxf(l0, fmaxf(l1, l2)), e0 = ex2(l0 - mx), e1 = ex2(l1 - mx), e2 = ex2(l2 - mx), ri = 1.f / (e0 + e1 + e2);
                const v4u w1 = R.p1[j - 2], w2 = R.p2[j - 2];
                const float a0 = e0 * ri, a1 = e1 * ri, a2 = e2 * ri;
                v[j][0] = a0 * v[j][0] + a1 * bflo(w1.x) + a2 * bflo(w2.x); v[j][1] = a0 * v[j][1] + a1 * bfhi(w1.x) + a2 * bfhi(w2.x);
                v[j][2] = a0 * v[j][2] + a1 * bflo(w1.y) + a2 * bflo(w2.y); v[j][3] = a0 * v[j][3] + a1 * bfhi(w1.y) + a2 * bfhi(w2.y);
                v[j][4] = a0 * v[j][4] + a1 * bflo(w1.z) + a2 * bflo(w2.z); v[j][5] = a0 * v[j][5] + a1 * bfhi(w1.z) + a2 * bfhi(w2.z);
                v[j][6] = a0 * v[j][6] + a1 * bflo(w1.w) + a2 * bflo(w2.w); v[j][7] = a0 * v[j][7] + a1 * bfhi(w1.w) + a2 * bfhi(w2.w); }
            float s = 0.f;
#pragma unroll
            for (int e = 0; e < 8; ++e) s += v[j][e] * v[j][e];
            ss[j] = wave_sum(s); }
        const float ra = 1.f / sqrtf(ss[0] * (1.f / 512) + EPS), rb = 1.f / sqrtf(ss[1] * (1.f / 512) + EPS), rc = 1.f / sqrtf((ss[2] + ss[3]) * (1.f / 1024) + EPS);
#pragma unroll
        for (int j = 0; j < 4; ++j) { const float r = (j == 0) ? ra : (j == 1 ? rb : rc); v4u w;
            w.x = pk2(v[j][0] * r * g[j][0].x, v[j][1] * r * g[j][0].y); w.y = pk2(v[j][2] * r * g[j][0].z, v[j][3] * r * g[j][0].w);
            w.z = pk2(v[j][4] * r * g[j][1].x, v[j][5] * r * g[j][1].y); w.w = pk2(v[j][6] * r * g[j][1].z, v[j][7] * r * g[j][1].w); ((GAS v4u*)(YO + (size_t)m * DM) + lane)[64 * j] = w; } };
    for (int m = row_lo; m < row_hi; m += 2 * row_step) { YR R[2];
#pragma unroll
        for (int q = 0; q < 2; ++q) if (m + q * row_step < row_hi) load(R[q], m + q * row_step);
#pragma unroll
        for (int q = 0; q < 2; ++q) if (m + q * row_step < row_hi) finish(R[q], m + q * row_step); }
}

namespace att {
typedef float f32x16 __attribute__((ext_vector_type(16)));
typedef float f32x2_t __attribute__((ext_vector_type(2)));
typedef __bf16 bf16x2_t __attribute__((ext_vector_type(2)));
typedef short bf16x8 __attribute__((ext_vector_type(8)));
typedef short s16x4 __attribute__((ext_vector_type(4)));
typedef short v4i16_t __attribute__((ext_vector_type(4)));
#define ATT_MFMA(a, b, c) __builtin_amdgcn_mfma_f32_32x32x16_bf16(a, b, c, 0, 0, 0)
constexpr float THR = 8.f;
constexpr float NEG = -1e30f;
__device__ __forceinline__ unsigned cvtpk(float lo, float hi) { f32x2_t v = {lo, hi}; bf16x2_t b = __builtin_convertvector(v, bf16x2_t); return __builtin_bit_cast(unsigned, b); }
__device__ __forceinline__ s16x4 vtr(LAS const char* p) { return __builtin_bit_cast(s16x4, __builtin_amdgcn_ds_read_tr16_b64_v4i16((LAS v4i16_t*)p)); }
__device__ __forceinline__ float swapmax(float m) { float a, b; swap32(m, a, b); return fmaxf(a, b); }
__device__ __forceinline__ float swapsum(float m) { float a, b; swap32(m, a, b); return a + b; }
__device__ __forceinline__ int crowc(int r) { return (r & 3) + 8 * (r >> 2); }

template <int NKD> struct St { f32x16 o[NKD / 2]; float m, l; };

struct Mask { int on, sgn, thr; };
__device__ __forceinline__ Mask mk_none() { return Mask{0, 1, 0}; }
__device__ __forceinline__ Mask mk_diag() { return Mask{1, -1, 0}; }
__device__ __forceinline__ Mask mk_far(int incl) { return Mask{1, 1, incl ? 0 : 1}; }

template <int NKD>
__device__ __forceinline__ void step(St<NKD>& s, const bf16x8 (&qf)[NKD], const bf16x8 (&kf)[NKD], LAS const char* vimg, const f32x16& kbc, float tb, bool sel, const Mask mk, int r32, int hi) {
    f32x16 S = kbc;
#pragma unroll
    for (int i = 0; i < NKD; ++i) S = ATT_MFMA(kf[i], qf[i], S);
    if (mk.on) { const int sv = mk.sgn * (4 * hi - r32);
#pragma unroll
        for (int r = 0; r < 16; ++r) S[r] = (sv >= mk.thr - mk.sgn * crowc(r)) ? S[r] : NEG; }
    float mx = fmaxf(fmaxf(S[0], S[1]), fmaxf(S[2], S[3]));
#pragma unroll
    for (int r = 4; r < 16; r += 4) mx = fmaxf(mx, fmaxf(fmaxf(S[r], S[r + 1]), fmaxf(S[r + 2], S[r + 3])));
    mx = swapmax(mx);
    const float tmax = sel ? mx + tb : NEG;
    if (__any(tmax > s.m + THR)) { const float mn = fmaxf(s.m, tmax), a = ex2(s.m - mn); s.l *= a; s.m = mn;
#pragma unroll
        for (int c = 0; c < NKD / 2; ++c) s.o[c] *= a; }
    const float cm = sel ? tb - s.m : -INFINITY;
    float ps = 0.f;
#pragma unroll
    for (int r = 0; r < 16; ++r) { S[r] = ex2(S[r] + cm); ps += S[r]; }
    s.l += ps;
    v4u pw0, pw1;
    pw0.x = cvtpk(S[0], S[1]); pw0.y = cvtpk(S[2], S[3]); pw0.z = cvtpk(S[4], S[5]); pw0.w = cvtpk(S[6], S[7]);
    pw1.x = cvtpk(S[8], S[9]); pw1.y = cvtpk(S[10], S[11]); pw1.z = cvtpk(S[12], S[13]); pw1.w = cvtpk(S[14], S[15]);
    const bf16x8 pa0 = __builtin_bit_cast(bf16x8, pw0), pa1 = __builtin_bit_cast(bf16x8, pw1);
#pragma unroll
    for (int c = 0; c < NKD / 2; ++c) {
        const s16x4 a0 = vtr(vimg + c * 2048), a1 = vtr(vimg + c * 2048 + 512), b0 = vtr(vimg + c * 2048 + 1024), b1 = vtr(vimg + c * 2048 + 1536);
        const bf16x8 v0 = {a0[0], a0[1], a0[2], a0[3], a1[0], a1[1], a1[2], a1[3]}, v1 = {b0[0], b0[1], b0[2], b0[3], b1[0], b1[1], b1[2], b1[3]};
        s.o[c] = ATT_MFMA(v0, pa0, s.o[c]); s.o[c] = ATT_MFMA(v1, pa1, s.o[c]); }
}

template <int NKD> __device__ __forceinline__ void load_k(bf16x8 (&kf)[NKD], const bf16* krow) {
#pragma unroll
    for (int i = 0; i < NKD; ++i) kf[i] = *(const GAS bf16x8*)(krow + 16 * i); }
template <int NKD> __device__ __forceinline__ void load_v(v4u (&vr)[NKD], const bf16* vrow  , long rs16  ) {
#pragma unroll
    for (int p = 0; p < NKD; ++p) vr[p] = *(const GAS v4u*)(vrow + (p & 1) * rs16 + (p >> 1) * 32); }
template <int NKD> __device__ __forceinline__ void write_v(const v4u (&vr)[NKD], LAS char* vbuf, int lane) {
#pragma unroll
    for (int p = 0; p < NKD; ++p) *(LAS v4u*)(vbuf + p * 1024 + lane * 16) = vr[p]; }

template <int NKD, bool PREF>
__device__ __forceinline__ void run_tiles(St<NKD>& s, const bf16x8 (&qf)[NKD], const bf16* krow, const bf16* vrow, long rs16, long tstep, int nt, const f32x16& kbc, float tb0, float dtb, bool sel,
                                          const Mask m0, const Mask mfar, LAS char* vl, int lane) {
    const int r32 = lane & 31, hi = lane >> 5;
    const int troff = ((lane >> 4) & 1) * 32 + (lane & 3) * 8 + (4 * hi + ((lane & 15) >> 2)) * 64;
    bf16x8 kf[NKD]; v4u vr[NKD];
    load_k<NKD>(kf, krow); load_v<NKD>(vr, vrow, rs16); write_v<NKD>(vr, vl, lane);
    int buf = 0;
    for (int k = 0; k < nt; ++k) {
        const Mask mk = (k == 0) ? m0 : ((k == 4) ? mfar : mk_none());
        const float tb = tb0 + (float)k * dtb;
        if constexpr (PREF) {
            bf16x8 kn[NKD];
            const bool more = (k + 1 < nt);
            const bf16* kr2 = more ? krow + (long)(k + 1) * tstep : krow; const bf16* vr2 = more ? vrow + (long)(k + 1) * tstep : vrow;
            load_k<NKD>(kn, kr2); load_v<NKD>(vr, vr2, rs16);
            step<NKD>(s, qf, kf, vl + buf * (NKD * 1024) + troff, kbc, tb, sel, mk, r32, hi);
            buf ^= 1; write_v<NKD>(vr, vl + buf * (NKD * 1024), lane);
#pragma unroll
            for (int i = 0; i < NKD; ++i) kf[i] = kn[i];
        } else {
            step<NKD>(s, qf, kf, vl + troff, kbc, tb, sel, mk, r32, hi);
            if (k + 1 < nt) { load_k<NKD>(kf, krow + (long)(k + 1) * tstep); load_v<NKD>(vr, vrow + (long)(k + 1) * tstep, rs16); write_v<NKD>(vr, vl, lane); }
        }
    }
}

template <int NKD> __device__ __forceinline__ void st_init(St<NKD>& s, float m, float l) { s.m = m; s.l = l;
#pragma unroll
    for (int c = 0; c < NKD / 2; ++c)
#pragma unroll
        for (int r = 0; r < 16; ++r) s.o[c][r] = 0.f; }
template <int NKD> __device__ __forceinline__ void st_store(const St<NKD>& s, float rl, bf16* orow  , int hi) {
#pragma unroll
    for (int c = 0; c < NKD / 2; ++c)
#pragma unroll
        for (int g = 0; g < 4; ++g) { v2u w; w.x = cvtpk(s.o[c][4 * g] * rl, s.o[c][4 * g + 1] * rl); w.y = cvtpk(s.o[c][4 * g + 2] * rl, s.o[c][4 * g + 3] * rl);
            *(GAS v2u*)(orow + 32 * c + 8 * g + 4 * hi) = w; }
}
template <int NKD, class RowPtr> __device__ __forceinline__ void st_store_lds(const St<NKD>& s, float rl, LAS char* stg, int lane, RowPtr rowptr) {
    const int r32 = lane & 31, hi = lane >> 5; constexpr int ROWB = NKD * 32;
#pragma unroll
    for (int c = 0; c < NKD / 2; ++c)
#pragma unroll
        for (int g = 0; g < 4; ++g) { v2u w; w.x = cvtpk(s.o[c][4 * g] * rl, s.o[c][4 * g + 1] * rl); w.y = cvtpk(s.o[c][4 * g + 2] * rl, s.o[c][4 * g + 3] * rl);
            *(LAS v2u*)(stg + r32 * ROWB + (((8 * c + 2 * g + hi) ^ (r32 & 15)) << 3)) = w; }
    constexpr int LPR = NKD * 2  , RPP = 64 / LPR  ;
#pragma unroll
    for (int j = 0; j < 32 / RPP; ++j) { const int row = lane / LPR + RPP * j, ch = lane % LPR;
        const v2u a0 = *(const LAS v2u*)(stg + row * ROWB + (((2 * ch) ^ (row & 15)) << 3)), a1 = *(const LAS v2u*)(stg + row * ROWB + (((2 * ch + 1) ^ (row & 15)) << 3));
        v4u w; w.x = a0.x; w.y = a0.y; w.z = a1.x; w.w = a1.y;
        *(GAS v4u*)(rowptr(row) + ch * 8) = w; }
}
template <int NKD> __device__ __forceinline__ void load_q(bf16x8 (&qf)[NKD], const bf16* qrow  ) {
#pragma unroll
    for (int i = 0; i < NKD; ++i) qf[i] = *(const GAS bf16x8*)(qrow + 16 * i); }
__device__ __forceinline__ void make_kbc(f32x16& kbc, float sl  , int hi) {
#pragma unroll
    for (int r = 0; r < 16; ++r) kbc[r] = sl * (float)(crowc(r) + 4 * hi); }

__device__ __forceinline__ void band_item(const bf16* PJ, int brow, int qt0, int dd, int ut, int qcol, int kcol, int vcol, float slope2, int mode, float sink2,
                                          bf16* out  , int opitch, float* lse  , int lpitch, LAS char* vl, int lane) {
    const int r32 = lane & 31, hi = lane >> 5;
    bf16x8 qf[4]; load_q<4>(qf, PJ + (size_t)(brow + qt0 + r32 * dd) * INW + qcol + 8 * hi);
    const float sl = slope2 * (float)dd; f32x16 kbc; make_kbc(kbc, sl, hi);
    St<4> s; if (mode == 0) st_init<4>(s, sink2 + sl * (float)r32, hi == 0 ? 1.f : 0.f); else st_init<4>(s, NEG, 0.f);
    const int nt = (ut + 1 < 5) ? ut + 1 : 5;
    const bf16* t0 = PJ + (size_t)(brow + qt0) * INW;
    const long rs = (long)dd * INW;
    run_tiles<4, true>(s, qf, t0 + (long)r32 * rs + kcol + 8 * hi, t0 + (long)(lane >> 2) * rs + vcol + 8 * (lane & 3), 16 * rs, -32 * rs, nt, kbc, 0.f, -32.f * sl, true, mk_diag(), mk_far(mode), vl, lane);
    const float lt = swapsum(s.l), rl = 1.f / lt;
    st_store<4>(s, rl, out + (size_t)(brow + qt0 + r32 * dd) * opitch, hi);
    if (lse && hi == 0) lse[(size_t)(brow + qt0 + r32 * dd) * lpitch] = s.m + __builtin_amdgcn_logf(lt) - sl * (float)r32;
}

__device__ __forceinline__ void moba_item(const bf16* PJ, const float* KM, int b, int h, int blk, int w, bf16* O, LAS char* vl, int lane) {
    const int r32 = lane & 31, hi = lane >> 5, brow = b * SEQ, q0 = blk * 256 + 32 * w;
    bf16x8 qf[4]; load_q<4>(qf, PJ + (size_t)(brow + q0 + r32) * INW + QB + h * 64 + 8 * hi);
    const float slope2 = ex2(-(float)(h + 1)) * LOG2E; f32x16 kbc; make_kbc(kbc, slope2, hi);
    float g1 = -INFINITY, g2 = -INFINITY, g3 = -INFINITY; int i1 = -1, i2 = -1, i3 = -1;
    for (int n = 0; n < blk; ++n) { const float* km = KM + (size_t)(b * 16 + n) * 512 + h * 64 + 8 * hi; float g = 0.f;
#pragma unroll
        for (int i = 0; i < 4; ++i) { const f32x4 a = *(const GAS f32x4*)(km + 16 * i), c = *(const GAS f32x4*)(km + 16 * i + 4); const v4u wq = __builtin_bit_cast(v4u, qf[i]);
            g = fmaf(bflo(wq.x), a.x, g); g = fmaf(bfhi(wq.x), a.y, g); g = fmaf(bflo(wq.y), a.z, g); g = fmaf(bfhi(wq.y), a.w, g);
            g = fmaf(bflo(wq.z), c.x, g); g = fmaf(bfhi(wq.z), c.y, g); g = fmaf(bflo(wq.w), c.z, g); g = fmaf(bfhi(wq.w), c.w, g); }
        g = swapsum(g);
        if (g > g1) { g3 = g2; i3 = i2; g2 = g1; i2 = i1; g1 = g; i1 = n; } else if (g > g2) { g3 = g2; i3 = i2; g2 = g; i2 = n; } else if (g > g3) { g3 = g; i3 = n; } }
    unsigned selmask = 0u; if (i1 >= 0) selmask |= 1u << i1; if (i2 >= 0) selmask |= 1u << i2; if (i3 >= 0) selmask |= 1u << i3;
    St<4> s; st_init<4>(s, NEG, 0.f);
    const bf16* t0 = PJ + (size_t)(brow + q0) * INW;
    const long rs = INW;
    run_tiles<4, true>(s, qf, t0 + (long)r32 * rs + KB + h * 64 + 8 * hi, t0 + (long)(lane >> 2) * rs + VB + h * 64 + 8 * (lane & 3), 16 * rs, -32 * rs, w + 1, kbc, 0.f, -32.f * slope2, true, mk_diag(), mk_none(), vl, lane);
    for (int n = blk - 1; n >= 0; --n) { const bool sel = (selmask >> n) & 1u; if (!__any(sel)) continue;
        const long off = (long)((n - blk) * 256 + 224 - 32 * w) * rs;
        run_tiles<4, true>(s, qf, t0 + off + (long)r32 * rs + KB + h * 64 + 8 * hi, t0 + off + (long)(lane >> 2) * rs + VB + h * 64 + 8 * (lane & 3), 16 * rs, -32 * rs, 8, kbc,
                           slope2 * (float)((n - blk) * 256 + 224 - 32 * w), -32.f * slope2, sel, mk_none(), mk_none(), vl, lane); }
    const float rl = 1.f / swapsum(s.l);
    st_store<4>(s, rl, O + (size_t)(brow + q0 + r32) * DM + 512 + h * 64, hi);
}

__device__ __forceinline__ void xattn_item(const bf16* QX, const bf16* KVX  , int b, int h, int qt, bf16* OX, LAS char* vl, int lane) {
    const int r32 = lane & 31, hi = lane >> 5;
    bf16x8 qf[8]; load_q<8>(qf, QX + (size_t)(b * SEQ + qt * 32 + r32) * XW + h * 128 + 8 * hi);
    f32x16 kbc;
#pragma unroll
    for (int r = 0; r < 16; ++r) kbc[r] = 0.f;
    St<8> s; st_init<8>(s, NEG, 0.f);
    const bf16* t0 = KVX + (size_t)(b * MEML) * 1024 + h * 128;
    run_tiles<8, false>(s, qf, t0 + (long)r32 * 1024 + 8 * hi, t0 + (long)(lane >> 2) * 1024 + 512 + 8 * (lane & 3), 16 * 1024, 32 * 1024, 8, kbc, 0.f, 0.f, true, mk_none(), mk_none(), vl, lane);
    const float rl = 1.f / swapsum(s.l);
    bf16* ob = OX + (size_t)(b * SEQ + qt * 32) * XW + h * 128;
    st_store_lds<8>(s, rl, vl + 8192, lane, [&](int row) { return ob + (size_t)row * XW; });
}
}

__device__ __forceinline__ void mix_b_phase(const bf16* PJ, const float* KM, bf16* O, LAS char* vl, int vcu, int wave, int lane) {
    for (int pi = 0; pi < 2; ++pi) { const int p = vcu * 2 + pi, b = p >> 6, h = (p >> 3) & 7, pr = p & 7;
        att::moba_item(PJ, KM, b, h, 15 - pr, wave, O, vl, lane);
        att::moba_item(PJ, KM, b, h, pr, wave, O, vl, lane); }
}
__device__ __forceinline__ void mix_c_phase(const bf16* PJ, bf16* O, bf16* PART, float* LSE, LAS char* vl, int vcu, int wave, int lane) {
    for (int k = 0; k < 24; ++k) { const int idx = (vcu * 24 + k) * 8 + wave, pat = idx >> 14, rem = idx & 16383, b = rem >> 11, h = (rem >> 7) & 15, qt = rem & 127;
        const int dd = (pat == 0) ? 1 : (pat == 1 ? 4 : 16), tpr = 128 / dd  , r = qt / tpr, ut = qt % tpr;
        const float slope2 = ex2(-0.5f * (float)(h + 1)) * LOG2E;
        bf16* out = (pat == 0) ? O + 1024 + h * 64 : PART + (size_t)(pat - 1) * M * 1024 + h * 64;
        att::band_item(PJ, b * SEQ, ut * 32 * dd + r, dd, ut, QC + h * 64, KC + h * 64, VC + h * 64, slope2, 1, 0.f, out, (pat == 0) ? DM : 1024, LSE + (size_t)pat * M * 16 + h, 16, vl, lane); }
}
__device__ __forceinline__ void mix_a_phase(const bf16* PJ, const float* sinks, bf16* O, LAS char* vl, int vcu, int wave, int lane) {
    for (int k = 0; k < 4; ++k) { const int au = vcu * 4 + k, b = au >> 7, kvh = (au >> 6) & 1, chunk = au & 63, h = kvh * 4 + (wave >> 1), qt = chunk * 2 + (wave & 1);
        const float slope2 = ex2(-(float)(h + 1)) * LOG2E;
        att::band_item(PJ, b * SEQ, qt * 32, 1, qt, QA + h * 64, KA + kvh * 64, VA + kvh * 64, slope2, 0, sinks[h] * LOG2E, O + h * 64, DM, nullptr, 0, vl, lane); }
}
__device__ __forceinline__ void mix_x_phase(const bf16* QX, const bf16* KVX, bf16* OX, LAS char* vl, int vcu, int wave, int lane) {
    for (int k = 0; k < 2; ++k) { const int idx = (vcu * 2 + k) * 8 + wave, b = idx >> 9, h = (idx >> 7) & 3, qt = idx & 127;
        att::xattn_item(QX, KVX, b, h, qt, OX, vl, lane); }
}

namespace att2 {
using namespace att;
constexpr int KIMG = 0, VIMG = 49152;
constexpr int MBUF = 65536, MV = 32768;
constexpr int KMS = RING_BYTES + 1024;
#define ATT2_BAR() asm volatile("s_waitcnt lgkmcnt(0)\n\ts_barrier" ::: "memory")

__device__ __forceinline__ int k_lds_off(int row  , int ch) { return row * 128 + ((ch ^ ((row >> 1) & 7)) << 4); }
__device__ __forceinline__ int v_lds_off(int row, int ch8) { return (ch8 >> 2) * 2048 + row * 64 + (ch8 & 3) * 16; }

__device__ __forceinline__ void lds_k(bf16x8 (&kf)[4], LAS const char* ktile, const int (&koff)[4]) {
#pragma unroll
    for (int i = 0; i < 4; ++i) kf[i] = *(const LAS bf16x8*)(ktile + koff[i]); }

__device__ __forceinline__ int imax3(int a, int b, int c) { return max(max(a, b), c); }
template <bool FIRST>
__device__ __forceinline__ void step2(St<4>& s, f32x16& L, const bf16x8 (&qf)[4], LAS const char* ktile, const int (&koff)[4], LAS const char* vimg, float sl, float tb, bool sel, const Mask mk, int r32, int hi) {
    bf16x8 kf[4]; lds_k(kf, ktile, koff);
    s16x4 va[8];
#pragma unroll
    for (int c = 0; c < 2; ++c) { va[4 * c] = vtr(vimg + c * 2048); va[4 * c + 1] = vtr(vimg + c * 2048 + 512); va[4 * c + 2] = vtr(vimg + c * 2048 + 1024); va[4 * c + 3] = vtr(vimg + c * 2048 + 1536); }
    __builtin_amdgcn_sched_barrier(0);
    f32x16 S; { float slo = sl; asm volatile("" : "+v"(slo));
      float base = fmaf(slo, (float)(4 * hi), tb); if (!FIRST) base = sel ? base - s.m : -INFINITY;
#pragma unroll
      for (int r = 0; r < 16; ++r) S[r] = fmaf(slo, (float)crowc(r), base); }
#pragma unroll
    for (int i = 0; i < 4; ++i) S = ATT_MFMA(kf[i], qf[i], S);
    if (mk.on) { const int sv = mk.sgn * (4 * hi - r32);
#pragma unroll
        for (int r = 0; r < 16; ++r) S[r] = (sv >= mk.thr - mk.sgn * crowc(r)) ? S[r] : NEG; }
    if (FIRST) {
        float mx = fmaxf(fmaxf(S[0], S[1]), fmaxf(S[2], S[3]));
#pragma unroll
        for (int r = 4; r < 16; r += 4) mx = fmaxf(mx, fmaxf(fmaxf(S[r], S[r + 1]), fmaxf(S[r + 2], S[r + 3])));
        mx = swapmax(mx);
        if (__any(mx > s.m + THR)) { const float mn = fmaxf(s.m, mx), a = ex2(s.m - mn); L *= a; s.m = mn; s.o[0] *= a; s.o[1] *= a; }
        const float cm = -s.m;
#pragma unroll
        for (int r = 0; r < 16; ++r) S[r] += cm;
    } else {
        int mb = imax3(__float_as_int(S[0]), __float_as_int(S[1]), __float_as_int(S[2]));
#pragma unroll
        for (int r = 3; r < 15; r += 2) mb = imax3(mb, __float_as_int(S[r]), __float_as_int(S[r + 1]));
        mb = max(mb, __float_as_int(S[15]));
        if (__any(__int_as_float(mb) > THR)) {
            float mx = fmaxf(fmaxf(S[0], S[1]), fmaxf(S[2], S[3]));
#pragma unroll
            for (int r = 4; r < 16; r += 4) mx = fmaxf(mx, fmaxf(fmaxf(S[r], S[r + 1]), fmaxf(S[r + 2], S[r + 3])));
            mx = swapmax(mx);
            const float d = fmaxf(mx, 0.f), a = ex2(-d); s.m += d; L *= a; s.o[0] *= a; s.o[1] *= a;
#pragma unroll
            for (int r = 0; r < 16; ++r) S[r] -= d; }
    }
#pragma unroll
    for (int r = 0; r < 16; ++r) S[r] = ex2(S[r]);
    v4u pw0, pw1;
    pw0.x = cvtpk(S[0], S[1]); pw0.y = cvtpk(S[2], S[3]); pw0.z = cvtpk(S[4], S[5]); pw0.w = cvtpk(S[6], S[7]);
    pw1.x = cvtpk(S[8], S[9]); pw1.y = cvtpk(S[10], S[11]); pw1.z = cvtpk(S[12], S[13]); pw1.w = cvtpk(S[14], S[15]);
    const bf16x8 pa0 = __builtin_bit_cast(bf16x8, pw0), pa1 = __builtin_bit_cast(bf16x8, pw1);
    { const v4u o1 = {0x3f803f80u, 0x3f803f80u, 0x3f803f80u, 0x3f803f80u}; const bf16x8 ones = __builtin_bit_cast(bf16x8, o1); L = ATT_MFMA(ones, pa0, L); L = ATT_MFMA(ones, pa1, L); }
#pragma unroll
    for (int c = 0; c < 2; ++c) {
        const bf16x8 v0 = {va[4 * c][0], va[4 * c][1], va[4 * c][2], va[4 * c][3], va[4 * c + 1][0], va[4 * c + 1][1], va[4 * c + 1][2], va[4 * c + 1][3]};
        const bf16x8 v1 = {va[4 * c + 2][0], va[4 * c + 2][1], va[4 * c + 2][2], va[4 * c + 2][3], va[4 * c + 3][0], va[4 * c + 3][1], va[4 * c + 3][2], va[4 * c + 3][3]};
        s.o[c] = ATT_MFMA(v0, pa0, s.o[c]); s.o[c] = ATT_MFMA(v1, pa1, s.o[c]); }
}

struct BandJob { const bf16* row0; int dd, U0, T; int kcol, vcol; };
template <int NP, int VOFF>
__device__ __forceinline__ void band_prefetch(v4u (&kp)[6], v4u (&vp)[6], const BandJob& J, int tid) {
    const bf16* base = J.row0 + J.kcol; const unsigned rp = (unsigned)(J.dd * INW * 2);
#pragma unroll
    for (int j = 0; j < NP; ++j) { int pos = J.U0 - 128 + (tid >> 3) + 64 * j; pos = pos < 0 ? 0 : pos;
        const unsigned off = (unsigned)pos * rp + (unsigned)((tid & 7) * 16);
        asm volatile("global_load_dwordx4 %0, %1, %2" : "=v"(kp[j]) : "v"(off), "s"(base) : "memory");
        asm volatile("global_load_dwordx4 %0, %1, %2 offset:%3" : "=v"(vp[j]) : "v"(off), "s"(base), "n"(VOFF) : "memory"); }
}
template <int NP, int N>
__device__ __forceinline__ void band_wait(v4u (&kp)[6], v4u (&vp)[6]) {
    __builtin_amdgcn_s_waitcnt(0x0F70 | N);
#pragma unroll
    for (int j = 0; j < NP; ++j) asm volatile("" : "+v"(kp[j]), "+v"(vp[j]));
}
template <int NP>
__device__ __forceinline__ void band_write(const v4u (&kp)[6], const v4u (&vp)[6], LAS char* lds, int tid) {
#pragma unroll
    for (int j = 0; j < NP; ++j) { const int row = (tid >> 3) + 64 * j, t = row >> 5, r = row & 31;
        *(LAS v4u*)(lds + KIMG + t * 4096 + k_lds_off(r, tid & 7)) = kp[j];
        *(LAS v4u*)(lds + VIMG + t * 4096 + v_lds_off(r, tid & 7)) = vp[j]; }
}
__device__ __forceinline__ void band_compute(const BandJob& J, int qi, const bf16x8 (&qf)[4], float slope2, int mode, float sink2, bf16* out, int opitch, float* lse, int lpitch, LAS char* lds, LAS char* stg, int lane) {
    const int r32 = lane & 31, hi = lane >> 5, ut = (J.U0 >> 5) + qi;
    const size_t qoff = (size_t)(J.U0 + 32 * qi + r32) * J.dd;
    const float sl = slope2 * (float)J.dd;
    St<4> s; st_init<4>(s, (mode == 0) ? sink2 + sl * (float)r32 : NEG, 0.f);
    f32x16 L;
#pragma unroll
    for (int r = 0; r < 16; ++r) L[r] = (mode == 0) ? 1.f : 0.f;
    int koff[4];
#pragma unroll
    for (int i = 0; i < 4; ++i) koff[i] = k_lds_off(r32, 2 * i + hi);
    const int troff = ((lane >> 4) & 1) * 32 + (lane & 3) * 8 + (4 * hi + ((lane & 15) >> 2)) * 64;
    const int nt = (ut + 1 < 5) ? ut + 1 : 5;
    step2<true>(s, L, qf, lds + KIMG + (qi + 4) * 4096, koff, lds + VIMG + (qi + 4) * 4096 + troff, sl, 0.f, true, mk_diag(), r32, hi);
    for (int k = 1; k < nt; ++k) { const int t = qi + 4 - k;
        step2<false>(s, L, qf, lds + KIMG + t * 4096, koff, lds + VIMG + t * 4096 + troff, sl, -32.f * sl * (float)k, true, (k == 4) ? mk_far(mode) : mk_none(), r32, hi); }
    const float lt = L[0], rl = __builtin_amdgcn_rcpf(lt);
    { const size_t q0r = (size_t)(J.U0 + 32 * qi) * J.dd * opitch, rstep = (size_t)J.dd * opitch;
      st_store_lds<4>(s, rl, stg, lane, [&](int row) { return out + q0r + (size_t)row * rstep; }); }
    if (mode == 1) lse[qoff * lpitch] = s.m + __builtin_amdgcn_logf(lt) - sl * (float)r32;
}

__device__ __forceinline__ void c_decode(const bf16* PJ, int vcu  , int k, BandJob& J, int& pat, int& b, int& h, int& r) { b = vcu >> 5; const int loc = k * 32 + (vcu & 31); h = loc / 48; const int rem = loc - h * 48; pat = rem >> 4; const int qg = rem & 15;
    const int dd = (pat == 0) ? 1 : (pat == 1 ? 4 : 16), tpr = 128 / dd, qt = qg * 8; r = qt / tpr; const int ut0 = qt % tpr;
    J.row0 = PJ + (size_t)(b * SEQ + r) * INW; J.dd = dd; J.U0 = ut0 * 32; J.T = 12; J.kcol = KC + h * 64; J.vcol = VC + h * 64; }
__device__ __forceinline__ void a_decode(const bf16* PJ, int au, BandJob& J, int& b, int& kvh) { b = au >> 7; kvh = (au >> 6) & 1; const int chunk = au & 63;
    J.row0 = PJ + (size_t)(b * SEQ) * INW; J.dd = 1; J.U0 = chunk * 64; J.T = 6; J.kcol = KA + kvh * 64; J.vcol = VA + kvh * 64; }
__device__ __forceinline__ void band_load_q(bf16x8 (&qf)[4], const BandJob& J, int qi, int qcol, int lane) { load_q<4>(qf, J.row0 + (size_t)(J.U0 + 32 * qi + (lane & 31)) * J.dd * INW + qcol + 8 * (lane >> 5)); }
__device__ __forceinline__ void mix_ca_phase(const bf16* PJ, const float* sinks, bf16* O, bf16* PART, float* LSE, LAS char* lds, int vcu, int wave, int lane) {
    const int tid = wave * 64 + lane;
    v4u kp[6], vp[6]; bf16x8 qf[4], qn[4];
    LAS char* stg = lds + 98304 + wave * 4096;
    {   BandJob J; int pat, b, h, r; c_decode(PJ, vcu, 0, J, pat, b, h, r); band_prefetch<6, (VC - KC) * 2>(kp, vp, J, tid); band_load_q(qf, J, wave, QC + h * 64, lane); band_wait<6, 0>(kp, vp);
        for (int k = 0; k < 24; ++k) {
            ATT2_BAR(); band_write<6>(kp, vp, lds, tid); ATT2_BAR();
            BandJob Jn = J; int patn = pat, bn = b, hn = h, rn = r; if (k + 1 < 24) { c_decode(PJ, vcu, k + 1, Jn, patn, bn, hn, rn); band_prefetch<6, (VC - KC) * 2>(kp, vp, Jn, tid); band_load_q(qn, Jn, wave, QC + hn * 64, lane); }
            const float slope2 = ex2(-0.5f * (float)(h + 1)) * LOG2E; const int op = (pat == 0) ? DM : 1024;
            bf16* out = (pat == 0) ? O + (size_t)(b * SEQ + r) * DM + 1024 + h * 64 : PART + ((size_t)(pat - 1) * M + (size_t)(b * SEQ + r)) * 1024 + h * 64;
            band_compute(J, wave, qf, slope2, 1, 0.f, out, op, LSE + ((size_t)pat * M + (size_t)(b * SEQ + r)) * 16 + h, 16, lds, stg, lane);
            band_wait<6, 5>(kp, vp);
            J = Jn; pat = patn; b = bn; h = hn; r = rn;
#pragma unroll
            for (int i = 0; i < 4; ++i) qf[i] = qn[i]; }
    }
    {   BandJob J; int b, kvh; a_decode(PJ, vcu * 4, J, b, kvh); band_prefetch<3, (VA - KA) * 2>(kp, vp, J, tid); band_load_q(qf, J, wave & 1, QA + (kvh * 4 + (wave >> 1)) * 64, lane);
        const float sink2 = sinks[kvh * 4 + (wave >> 1)] * LOG2E;
        band_wait<3, 0>(kp, vp);
        for (int k = 0; k < 4; ++k) {
            ATT2_BAR(); band_write<3>(kp, vp, lds, tid); ATT2_BAR();
            BandJob Jn = J; int bn = b, kvhn = kvh; if (k + 1 < 4) { a_decode(PJ, vcu * 4 + k + 1, Jn, bn, kvhn); band_prefetch<3, (VA - KA) * 2>(kp, vp, Jn, tid); band_load_q(qn, Jn, wave & 1, QA + (kvhn * 4 + (wave >> 1)) * 64, lane); }
            const int h = kvh * 4 + (wave >> 1); const float slope2 = ex2(-(float)(h + 1)) * LOG2E;
            band_compute(J, wave & 1, qf, slope2, 0, sink2, O + (size_t)(b * SEQ) * DM + h * 64, DM, nullptr, 0, lds, stg, lane);
            band_wait<3, 4>(kp, vp);
            J = Jn; b = bn; kvh = kvhn;
#pragma unroll
            for (int i = 0; i < 4; ++i) qf[i] = qn[i]; }
    }
    ATT2_BAR();
}

__device__ __forceinline__ void moba_prefetch(v4u (&kp)[4], v4u (&vp)[4], const bf16* blk0  , int tid) {
#pragma unroll
    for (int j = 0; j < 4; ++j) { const bf16* r = blk0 + (size_t)((tid >> 3) + 64 * j) * INW + (tid & 7) * 8; kp[j] = *(const GAS v4u*)r; vp[j] = *(const GAS v4u*)(r + (VB - KB)); }
}
__device__ __forceinline__ void moba_write(const v4u (&kp)[4], const v4u (&vp)[4], LAS char* buf, int tid) {
#pragma unroll
    for (int j = 0; j < 4; ++j) { const int row = (tid >> 3) + 64 * j, t = row >> 5, r = row & 31;
        *(LAS v4u*)(buf + t * 4096 + k_lds_off(r, tid & 7)) = kp[j];
        *(LAS v4u*)(buf + MV + t * 4096 + v_lds_off(r, tid & 7)) = vp[j]; }
}
__device__ __forceinline__ void moba_wg_item(const bf16* PJ, const float* KM, int b, int h, int blk, bf16* O, LAS char* lds, int wave, int lane) {
    const int tid = wave * 64 + lane, r32 = lane & 31, hi = lane >> 5, w = wave, brow = b * SEQ, q0 = blk * 256 + 32 * w;
    const bf16* kb0 = PJ + (size_t)brow * INW + KB + h * 64;
    v4u kp[4], vp[4];
    moba_prefetch(kp, vp, kb0 + (size_t)(blk * 256) * INW, tid);
    ATT2_BAR();
    if (tid < blk * 16) *(LAS f32x4*)(lds + KMS + tid * 16) = *(const GAS f32x4*)(KM + (size_t)(b * 16 + (tid >> 4)) * 512 + h * 64 + (tid & 15) * 4);
    bf16x8 qf[4]; load_q<4>(qf, PJ + (size_t)(brow + q0 + r32) * INW + QB + h * 64 + 8 * hi);
    const float slope2 = ex2(-(float)(h + 1)) * LOG2E;
    moba_write(kp, vp, lds, tid);
    ATT2_BAR();
    if (blk > 0) moba_prefetch(kp, vp, kb0 + (size_t)((blk - 1) * 256) * INW, tid);
    float g1 = -INFINITY, g2 = -INFINITY, g3 = -INFINITY; int i1 = -1, i2 = -1, i3 = -1;
    for (int n = 0; n < blk; ++n) { const LAS float* km = (const LAS float*)(lds + KMS) + n * 64 + 8 * hi; float g = 0.f;
#pragma unroll
        for (int i = 0; i < 4; ++i) { const f32x4 a = *(const LAS f32x4*)(km + 16 * i), c = *(const LAS f32x4*)(km + 16 * i + 4); const v4u wq = __builtin_bit_cast(v4u, qf[i]);
            g = fmaf(bflo(wq.x), a.x, g); g = fmaf(bfhi(wq.x), a.y, g); g = fmaf(bflo(wq.y), a.z, g); g = fmaf(bfhi(wq.y), a.w, g);
            g = fmaf(bflo(wq.z), c.x, g); g = fmaf(bfhi(wq.z), c.y, g); g = fmaf(bflo(wq.w), c.z, g); g = fmaf(bfhi(wq.w), c.w, g); }
        g = swapsum(g);
        if (g > g1) { g3 = g2; i3 = i2; g2 = g1; i2 = i1; g1 = g; i1 = n; } else if (g > g2) { g3 = g2; i3 = i2; g2 = g; i2 = n; } else if (g > g3) { g3 = g; i3 = n; } }
    unsigned selmask = 0u; if (i1 >= 0) selmask |= 1u << i1; if (i2 >= 0) selmask |= 1u << i2; if (i3 >= 0) selmask |= 1u << i3;
    St<4> s; st_init<4>(s, NEG, 0.f);
    f32x16 L;
#pragma unroll
    for (int r = 0; r < 16; ++r) L[r] = 0.f;
    int koff[4];
#pragma unroll
    for (int i = 0; i < 4; ++i) koff[i] = k_lds_off(r32, 2 * i + hi);
    const int troff = ((lane >> 4) & 1) * 32 + (lane & 3) * 8 + (4 * hi + ((lane & 15) >> 2)) * 64;
    { step2<true>(s, L, qf, lds + w * 4096, koff, lds + MV + w * 4096 + troff, slope2, 0.f, true, mk_diag(), r32, hi);
      for (int k = 1; k <= w; ++k) { const int t = w - k;
        step2<false>(s, L, qf, lds + t * 4096, koff, lds + MV + t * 4096 + troff, slope2, -32.f * slope2 * (float)k, true, mk_none(), r32, hi); } }
    for (int j = 1; j <= blk; ++j) { const int n = blk - j; LAS char* buf = lds + (j & 1) * MBUF;
        moba_write(kp, vp, buf, tid);
        ATT2_BAR();
        if (j < blk) moba_prefetch(kp, vp, kb0 + (size_t)((n - 1) * 256) * INW, tid);
        const bool sel = (selmask >> n) & 1u;
        if (__any(sel)) { const float tb0 = slope2 * (float)((n - blk) * 256 + 224 - 32 * w);
            for (int k = 0; k < 8; ++k) { const int t = 7 - k;
                step2<false>(s, L, qf, buf + t * 4096, koff, buf + MV + t * 4096 + troff, slope2, tb0 - 32.f * slope2 * (float)k, sel, mk_none(), r32, hi); } } }
    const float rl = __builtin_amdgcn_rcpf(L[0]);
    { bf16* ob = O + (size_t)(brow + q0) * DM + 512 + h * 64;
      st_store_lds<4>(s, rl, lds + ((blk + 1) & 1) * MBUF + wave * 4096, lane, [&](int row) { return ob + (size_t)row * DM; }); }
}
__device__ __forceinline__ void mix_b2_phase(const bf16* PJ, const float* KM, bf16* O, LAS char* lds, int vcu, int wave, int lane) {
    for (int pi = 0; pi < 2; ++pi) { const int b = vcu >> 5, tr = vcu & 31, h = pi * 4 + (tr >> 3), pr = tr & 7;
        moba_wg_item(PJ, KM, b, h, 15 - pr, O, lds, wave, lane);
        moba_wg_item(PJ, KM, b, h, pr, O, lds, wave, lane); }
    ATT2_BAR();
}
}

namespace att2 {
__device__ __forceinline__ void xattn_wg(const bf16* QX, const bf16* KVX  , bf16* OX, int pm, int pn, LAS char* lds, int wave, int lane) {
    const int tid = wave * 64 + lane, r32 = lane & 31, hi = lane >> 5, b = pm >> 4;
    const int troff = ((lane >> 4) & 1) * 32 + (lane & 3) * 8 + (4 * hi + ((lane & 15) >> 2)) * 64;
    int koff[8];
#pragma unroll
    for (int i = 0; i < 8; ++i) koff[i] = r32 * 256 + (((2 * i + hi) ^ (r32 & 15)) << 4);
    asm volatile("s_waitcnt vmcnt(0)" ::: "memory");
    for (int hh = 0; hh < 2; ++hh) { const int h = 2 * pn + hh;
        ATT2_BAR();
        { const bf16* src = KVX + (size_t)(b * MEML) * 1024 + h * 128 + (tid & 15) * 8;
#pragma unroll
          for (int j = 0; j < 8; ++j) { const int row = (tid >> 4) + 32 * j, ch = tid & 15; const v4u kk = *(const GAS v4u*)(src + (size_t)row * 1024), vv = *(const GAS v4u*)(src + (size_t)row * 1024 + 512);
              *(LAS v4u*)(lds + j * 8192 + (row & 31) * 256 + ((ch ^ (row & 15)) << 4)) = kk;
              *(LAS v4u*)(lds + 65536 + j * 8192 + (ch >> 2) * 2048 + (row & 31) * 64 + (ch & 3) * 16) = vv; } }
        bf16x8 qf[8]; load_q<8>(qf, QX + (size_t)(pm * 256 + wave * 32 + r32) * XW + h * 128 + 8 * hi);
        ATT2_BAR();
        St<8> s; st_init<8>(s, NEG, 0.f);
        f32x16 zero;
#pragma unroll
        for (int r = 0; r < 16; ++r) zero[r] = 0.f;
        for (int t = 0; t < 8; ++t) { bf16x8 kf[8];
#pragma unroll
            for (int i = 0; i < 8; ++i) kf[i] = *(const LAS bf16x8*)(lds + t * 8192 + koff[i]);
            step<8>(s, qf, kf, lds + 65536 + t * 8192 + troff, zero, 0.f, true, mk_none(), r32, hi); }
        const float rl = __builtin_amdgcn_rcpf(swapsum(s.l));
        ATT2_BAR();
        bf16* ob = OX + (size_t)(pm * 256 + wave * 32) * XW + h * 128;
        st_store_lds<8>(s, rl, lds + wave * 8192, lane, [&](int row) { return ob + (size_t)row * XW; });
    }
    ATT2_BAR();
}
}

#ifndef KM_ATOMIC
#define KM_ATOMIC 1
#endif
#ifndef RESID_ALIGN
#define RESID_ALIGN true
#endif
#ifndef FUSE_X
#define FUSE_X 1
#endif
#ifndef ATT_V2
#define ATT_V2 1
#endif
#ifndef MFMA_A
#define MFMA_A 1
#endif
#ifndef MFMA_B
#define MFMA_B 1
#endif
#ifndef MFMA_C
#define MFMA_C 1
#endif
#ifndef MFMA_X
#define MFMA_X 1
#endif
constexpr int PH_L0 = 2, PH_PER_LAYER = 9, PH_FINAL = PH_L0 + DEPTH * PH_PER_LAYER, PH_END = PH_FINAL + 1;
struct Args { Ptrs p; float* out; unsigned char* ws; int ph_lo, ph_hi, mixmask, pad; };
static_assert(sizeof(Args) == 22 * 8 + 16, "Args has no padding bytes");
__global__ void __launch_bounds__(NWAVES * 64, 2) trunk_fwd(Args args) {
    extern __shared__ __attribute__((aligned(16))) unsigned char lds_raw[];
    LAS unsigned char* lds = (LAS unsigned char*)lds_raw;
    volatile LAS unsigned* MISC = (volatile LAS unsigned*)(lds + MISC_OFF);
    const int tid = threadIdx.x, lane0 = tid & 63, wave = __builtin_amdgcn_readfirstlane(tid >> 6);
    const int G = gridDim.x; const int bx = blockIdx.x; const int vcu = (G % 8 == 0) ? (bx % 8) * (G / 8) + bx / 8 : bx;
    const int gw = vcu * NWAVES + wave, NGW = G * NWAVES, gtid0 = gw * 64 + lane0, nthr = NGW * 64;
    unsigned char* ws = args.ws; const Ptrs& P = args.p;
    gu32* ctl = (gu32*)(ws + WS_CTL);
    for (int u = tid; u < (LDS_BYTES - LDSCTL_OFF) / 4; u += NWAVES * 64) ((LAS unsigned*)(lds + LDSCTL_OFF))[u] = 0u;
    __syncthreads();
    XcdBarrier bar; bar.bar = (unsigned*)(ctl + CW_BAR); bar.x = xb_xcc_id(); bar.st = MISC + 8;
    if (tid == 0) MISC[10] = xcd_barrier_post_rank(bar.bar, bar.x);
    __syncthreads();
    const int xrank = __builtin_amdgcn_readfirstlane((int)MISC[10]);
    const int lo = args.ph_lo, hi = args.ph_hi;
#define IN(k) (lo <= (k) && (k) < hi)
#define SEAM(k) do { if (IN(k) && IN((k) + 1)) xcd_barrier2(bar, false); } while (0)
#define TSEAM(k) do { if (IN(k) && IN((k) + 1)) xcd_barrier2(bar, teams); } while (0)
    bf16* XN = (bf16*)(ws + WS_XN); bf16* BIG = (bf16*)(ws + WS_BIG); bf16* QX = (bf16*)(ws + WS_QX); bf16* OX = (bf16*)(ws + WS_OX);
    bf16* H16 = (bf16*)args.out;

    if (IN(0)) { p0_convert(P, ws, H16, (LAS char*)(lds + RING_OFF + wave * 16384), gw, NGW, lane0); }
    SEAM(0);
    bool teams = false;
    if (lo == 0 && hi == PH_END && G == 256) { if (tid == 0) { unsigned ok = 1u;
#pragma unroll
            for (unsigned j = 0; j < 16; ++j) { const unsigned c = xb_ld(&bar.bar[XB_XCNT(j)]); ok &= (j < 8u) ? (c == 32u) : (c == 0u); }
            MISC[11] = ok; }
        __syncthreads(); teams = __builtin_amdgcn_readfirstlane((int)MISC[11]) != 0; }
    const int vcu2 = teams ? (int)bar.x * 32 + xrank : vcu;
    for (int l = 0; l < DEPTH; ++l) {
        unsigned zl = 0u; asm volatile("" : "+s"(zl));
        int lane = (int)__builtin_amdgcn_mbcnt_hi(~0u, __builtin_amdgcn_mbcnt_lo(~0u, zl)), wave_l = wave, vcu_l = vcu2; asm volatile("" : "+v"(lane), "+s"(wave_l), "+s"(vcu_l));
        const int gtid = gw * 64 + lane; (void)gtid;
#define TEAMVARS int team = vcu_l >> 5, trank = vcu_l & 31; asm volatile("" : "+s"(team), "+s"(trank)); bf16* PJt = BIG + (size_t)team * (1u << 20); bf16* QXt = XN + (size_t)team * (6u << 20); bf16* OXt = XN + (2u << 20) + (size_t)team * (6u << 20); (void)PJt; (void)QXt; (void)OXt
        const int pb = PH_L0 + l * PH_PER_LAYER;
        unsigned char* wl = ws + WS_WL + (size_t)l * WL_STRIDE;
        float* KM = (float*)(ws + WS_KMEAN) + (size_t)l * (M / 256) * 512;
        unsigned long long* SS = (unsigned long long*)(ws + WS_SS) + (size_t)(3 * l) * M;
        bf16* PARTB = (bf16*)(ws + WS_PART);
#ifdef PROBE_DRY
        const bool dry = (args.mixmask & 8) != 0;
#else
        constexpr bool dry = false;
#endif
        bf16* RO = dry ? PARTB : H16; unsigned long long* SSD = (unsigned long long*)(ws + WS_SS) + (size_t)13 * M;
        if (IN(pb + 0)) { TEAMVARS; pg8::Gemm g{H16, (const bf16*)(wl + WL_IN), M, INW, DM}; pg8::TeamOrder S{INW / 256, team, trank};
            pg8::EpiBf16S E{PJt, INW, C2, (1u << 0) | (1u << 1) | (1u << 3) | (1u << 4) | (1u << 9) | (1u << 10) | (1u << 11) | (1u << 12), 0xff, SS, KM_ATOMIC ? KM : nullptr, (pg8::lds_f32*)(lds + RING_BYTES + 10240), (l * 4 + 1) << 9};
            pg8::gemm_phase<pg8::EpiBf16S, pg8::TeamOrder, true, true>(lds + RING_OFF, g, S, E, wave_l);
            if (trank >= 28) {
                const int ku = team * 4 + (trank - 28);
                pg8::Gemm gk{(const bf16*)(ws + WS_MEMN) + (size_t)l * MROWS * DM, (const bf16*)(ws + WS_WKV) + (size_t)l * 1024 * DM, MROWS, 1024, DM}; pg8::OneUnit SK{ku >> 2, ku & 3};
                pg8::EpiBf16S EK{(bf16*)(ws + WS_KVX) + (size_t)l * MROWS * 1024, 1024, 1.f, 0u, 0xff, nullptr, nullptr, (pg8::lds_f32*)(lds + RING_BYTES + 10240), 0};
                pg8::gemm_phase<pg8::EpiBf16S, pg8::OneUnit, true, true>(lds + RING_OFF, gk, SK, EK, wave_l); } }
        TSEAM(pb + 0);
#if !KM_ATOMIC
        if (IN(pb + 0)) { kmean_phase(BIG, KM, gw, NGW, lane); xcd_barrier2(bar, false); }
#endif
        if (IN(pb + 1)) { TEAMVARS;
#if ATT_V2
            if (args.mixmask & 1) att2::mix_b2_phase(PJt, KM, XN, (LAS char*)lds, vcu_l, wave_l, lane);
            if (args.mixmask & 6) att2::mix_ca_phase(PJt, P.sinks + l * 8, XN, PARTB, (float*)(ws + WS_LSE), (LAS char*)lds, vcu_l, wave_l, lane);
#else
            LAS char* vl = (LAS char*)(lds + RING_OFF + wave_l * 16384);
            if (args.mixmask & 1) mix_b_phase(BIG, KM, XN, vl, vcu_l, wave_l, lane);
            if (args.mixmask & 2) mix_c_phase(BIG, XN, PARTB, (float*)(ws + WS_LSE), vl, vcu_l, wave_l, lane);
            if (args.mixmask & 4) mix_a_phase(BIG, P.sinks + l * 8, XN, vl, vcu_l, wave_l, lane);
#endif
        }
        TSEAM(pb + 1);
        if (IN(pb + 2)) { TEAMVARS; ynorm_phase<MFMA_C != 0>(XN, dry ? BIG : XN, PARTB, (const float*)(ws + WS_LSE), P.gain_a + l * 512, P.gain_b + l * 512, P.gain_c + l * 1024, team * SEQ + trank * NWAVES + wave_l, (team + 1) * SEQ, 32 * NWAVES, lane); }
        TSEAM(pb + 2);
        if (IN(pb + 3)) { TEAMVARS; pg8::Gemm g{XN, (const bf16*)(wl + WL_OUT), M, DM, DM}; pg8::TeamOrder S{DM / 256, team, trank};
            pg8::EpiResid E{H16, RO, DM, dry ? SSD : SS + M, (LAS unsigned long long*)(lds + RING_BYTES + 8192)};
            pg8::gemm_phase<pg8::EpiResid, pg8::TeamOrder, RESID_ALIGN, true>(lds + RING_OFF, g, S, E, wave_l); }
        TSEAM(pb + 3);
        if (IN(pb + 4)) { TEAMVARS; pg8::Gemm g{H16, (const bf16*)(wl + WL_Q), M, XW, DM}; pg8::TeamOrder S{XW / 256, team, trank};
            pg8::EpiBf16S E{QXt, XW, CX2, 3u, 0xff, SS + M, nullptr, (pg8::lds_f32*)(lds + RING_BYTES + 10240), (l * 4 + 2) << 9};
            pg8::gemm_phase<pg8::EpiBf16S, pg8::TeamOrder, true, true>(lds + RING_OFF, g, S, E, wave_l);
#if FUSE_X
            pg8::Unit u; for (int i = 0; S.next(i, u); ++i) att2::xattn_wg(QXt, (const bf16*)(ws + WS_KVX) + (size_t)l * MROWS * 1024, OXt, u.pm, u.pn, (LAS char*)lds, wave_l, lane);
#endif
        }
        TSEAM(pb + 4);
#if !FUSE_X
#if MFMA_X
        if (IN(pb + 5)) mix_x_phase(QX, (const bf16*)(ws + WS_KVX) + (size_t)l * MROWS * 1024, OX, (LAS char*)(lds + RING_OFF + wave_l * 16384), vcu_l, wave_l, lane);
#else
        if (IN(pb + 5)) naive_attn_x(QX, (const bf16*)(ws + WS_KVX) + (size_t)l * MROWS * 1024, OX, gtid, nthr);
#endif
        TSEAM(pb + 5);
#endif
        if (IN(pb + 6)) { TEAMVARS; pg8::Gemm g{OXt, (const bf16*)(wl + WL_O), M, DM, XW}; pg8::TeamOrder S{DM / 256, team, trank};
            pg8::EpiResid E{H16, RO, DM, dry ? SSD : SS + 2 * M, (LAS unsigned long long*)(lds + RING_BYTES + 8192)};
            pg8::gemm_phase<pg8::EpiResid, pg8::TeamOrder, RESID_ALIGN, true>(lds + RING_OFF, g, S, E, wave_l); }
        TSEAM(pb + 6);
        if (IN(pb + 7)) { TEAMVARS; pg8::Gemm g{H16, (const bf16*)(wl + WL_GU), M, NGU, DM}; pg8::TeamOrder S{NGU / 256, team, trank};
            pg8::EpiSwiGLU E{BIG, DFF, SS + 2 * M, (args.mixmask & 32) ? 2 : ((args.mixmask & 16) ? 1 : 0), (pg8::lds_f32*)(lds + RING_BYTES + 10240), (l * 4 + 3) << 9};
            pg8::gemm_phase<pg8::EpiSwiGLU, pg8::TeamOrder, true, true>(lds + RING_OFF, g, S, E, wave_l); }
        TSEAM(pb + 7);
        if (IN(pb + 8)) { TEAMVARS; pg8::Gemm g{BIG, (const bf16*)(wl + WL_DN), M, DM, DFF}; pg8::TeamOrder S{DM / 256, team, trank};
            pg8::EpiResid E{H16, dry ? PARTB : ((l == DEPTH - 1) ? XN : H16), DM, dry ? SSD : SS + 3 * M, (LAS unsigned long long*)(lds + RING_BYTES + 8192)};
            pg8::gemm_phase<pg8::EpiResid, pg8::TeamOrder, RESID_ALIGN, true>(lds + RING_OFF, g, S, E, wave_l); }
        if (l == DEPTH - 1) SEAM(pb + 8); else TSEAM(pb + 8);
    }
    if (IN(PH_FINAL)) {
        unsigned zl = 0u; asm volatile("" : "+s"(zl));
        int lane = (int)__builtin_amdgcn_mbcnt_hi(~0u, __builtin_amdgcn_mbcnt_lo(~0u, zl)), gwf = gw; asm volatile("" : "+v"(lane), "+s"(gwf));
        f32x4 g[4][2];
#pragma unroll
        for (int j = 0; j < 4; ++j) { g[j][0] = *(const GAS f32x4*)(P.norm_final + 512 * j + 8 * lane); g[j][1] = *(const GAS f32x4*)(P.norm_final + 512 * j + 8 * lane + 4); }
        int team = vcu2 >> 5, trank = vcu2 & 31; asm volatile("" : "+s"(team), "+s"(trank)); (void)gwf;
        for (int m0 = team * SEQ + trank * NWAVES + wave; m0 < (team + 1) * SEQ; m0 += 2 * 32 * NWAVES) { v4u w4[2][4];
#pragma unroll
            for (int q = 0; q < 2; ++q) { const GAS v4u* row = (const GAS v4u*)(XN + (size_t)(m0 + q * 32 * NWAVES) * DM) + lane;
#pragma unroll
                for (int j = 0; j < 4; ++j) w4[q][j] = row[64 * j]; }
#pragma unroll
            for (int q = 0; q < 2; ++q) { const int m = m0 + q * 32 * NWAVES; float v[4][8]; float s = 0.f;
#pragma unroll
                for (int j = 0; j < 4; ++j) { const v4u w = w4[q][j]; v[j][0] = bflo(w.x); v[j][1] = bfhi(w.x); v[j][2] = bflo(w.y); v[j][3] = bfhi(w.y); v[j][4] = bflo(w.z); v[j][5] = bfhi(w.z); v[j][6] = bflo(w.w); v[j][7] = bfhi(w.w);
#pragma unroll
                    for (int e2 = 0; e2 < 8; ++e2) s += v[j][e2] * v[j][e2]; }
                const float rstd = 1.f / sqrtf(wave_sum(s) * (1.f / DM) + EPS);
                GAS f32x4* o = (GAS f32x4*)(args.out + (size_t)m * DM + 8 * lane);
#pragma unroll
                for (int j = 0; j < 4; ++j) { o[128 * j] = (f32x4){v[j][0] * rstd * g[j][0].x, v[j][1] * rstd * g[j][0].y, v[j][2] * rstd * g[j][0].z, v[j][3] * rstd * g[j][0].w};
                    o[128 * j + 1] = (f32x4){v[j][4] * rstd * g[j][1].x, v[j][5] * rstd * g[j][1].y, v[j][6] * rstd * g[j][1].z, v[j][7] * rstd * g[j][1].w}; } } }
    }
#undef IN
#undef SEAM
#undef TSEAM
}

#ifndef MK_MODE
#define MK_MODE 1
#endif
extern "C" void kernel_launch(void* const* d_in, const int* in_sizes, int n_in, void* d_out, int out_size, void* d_ws, size_t ws_size, hipStream_t stream) {
    static int grid = 0;
    if (grid == 0) {
        if (n_in != 20 || in_sizes[0] != M * DM || out_size != M * DM || ws_size < WS_END) { fprintf(stderr, "kernel_launch: unexpected shapes / workspace (%zu < %zu)\n", ws_size, (size_t)WS_END); grid = -1; return; }
        int dev = 0, cus = 0, per_cu = 0;
        if (hipGetDevice(&dev) != hipSuccess || hipDeviceGetAttribute(&cus, hipDeviceAttributeMultiprocessorCount, dev) != hipSuccess) { grid = -1; return; }
        if (hipFuncSetAttribute((const void*)trunk_fwd, hipFuncAttributeMaxDynamicSharedMemorySize, LDS_BYTES) != hipSuccess) { grid = -1; return; }
        if (hipOccupancyMaxActiveBlocksPerMultiprocessor(&per_cu, (const void*)trunk_fwd, NWAVES * 64, LDS_BYTES) != hipSuccess || per_cu < 1) { fprintf(stderr, "kernel_launch: occupancy query reports %d\n", per_cu); }
        (void)hipGetLastError();
        grid = cus;
        if (grid != 256) { fprintf(stderr, "kernel_launch: the static work deal of this kernel is built for 256 CUs (MI355X); found %d: nothing launched\n", cus); grid = -1; return; }
    }
    if (grid < 0) return;
    if (hipMemsetAsync((char*)d_ws + WS_CTL, 0, CTL_ZERO_BYTES, stream) != hipSuccess) return;
    if (hipMemsetAsync((char*)d_ws + WS_SS, 0, SS_BYTES, stream) != hipSuccess) return;
    Args a{};
    const float** pp = (const float**)&a.p;
    for (int i = 0; i < 20; ++i) pp[i] = (const float*)d_in[i];
    a.out = (float*)d_out; a.ws = (unsigned char*)d_ws; a.mixmask = 7;
#if MK_MODE == 1
    a.ph_lo = 0; a.ph_hi = PH_END;
    hipLaunchKernelGGL(trunk_fwd, dim3(grid), dim3(NWAVES * 64), LDS_BYTES, stream, a);
#else
    for (int k = 0; k < PH_END; ++k) {
        a.ph_lo = k; a.ph_hi = k + 1; a.mixmask = 7;
#ifdef PROBE_DRY
        if (k >= PH_L0 && k < PH_FINAL && (k - PH_L0) % PH_PER_LAYER == PROBE_DRY) { a.mixmask = 15; hipLaunchKernelGGL(trunk_fwd, dim3(grid), dim3(NWAVES * 64), LDS_BYTES, stream, a); a.mixmask = 7; }
#endif
        hipLaunchKernelGGL(trunk_fwd, dim3(grid), dim3(NWAVES * 64), LDS_BYTES, stream, a);
#ifdef PROBE_PH
        if ((PROBE_PH >= 0 && k >= PH_L0 && k < PH_FINAL && (k - PH_L0) % PH_PER_LAYER == PROBE_PH) || (PROBE_PH == -1 && k == 0) || (PROBE_PH == -2 && k == 1)) {
            a.mixmask = PROBE_MIX; hipLaunchKernelGGL(trunk_fwd, dim3(grid), dim3(NWAVES * 64), LDS_BYTES, stream, a); }
#endif
    }
#endif
}
```
